# Optimizing an MI355X kernel written in HIP

```python
import math
import jax, jax.numpy as jnp
from jax import lax
import numpy as np

D_MODEL = 1024
BATCH = 8
SEQ = 2048
DEPTH = 1
DEC_BATCH = 128
DEC_SEQ = 1
PAST_LEN = 16384
PAGE_SIZE = 128

HEAD_DIM = 64
ML_HEADS = D_MODEL // (2 * HEAD_DIM)
RW_HEADS = D_MODEL // (2 * HEAD_DIM)
ML_W = ML_HEADS * HEAD_DIM
RW_W = RW_HEADS * HEAD_DIM
MIX_W = ML_W + RW_W
CONV_W = 4
MLSTM_CHUNK = 64
D_DECAY_LORA = 64
D_AAA_LORA = 64
D_GATE_LORA = 128
D_FF = 4 * D_MODEL
EPS = 1e-6
GN_EPS = 64e-5
ML_IN_W = 4 * ML_W + 2 * ML_HEADS
RW_IN_W = 3 * RW_W + D_DECAY_LORA + D_AAA_LORA + D_GATE_LORA
IN_W = ML_IN_W + RW_IN_W

kernel_name = "hymba_mlstm_rwkv7_decode_step"


def rms_norm(x, w):
    xf = x.astype(jnp.float32)
    y = xf * lax.rsqrt(jnp.mean(xf * xf, axis=-1, keepdims=True) + EPS)
    return (y * w.astype(jnp.float32)).astype(x.dtype)


def head_rms_norm(h, w, n_heads):
    B, T, W = h.shape
    hf = h.astype(jnp.float32).reshape(B, T, n_heads, W // n_heads)
    hf = hf * lax.rsqrt(jnp.mean(hf * hf, axis=-1, keepdims=True) + EPS)
    return (hf.reshape(B, T, W) * w.astype(jnp.float32)).astype(h.dtype)


def head_group_norm(y, w, b, n_heads):
    B, T, W = y.shape
    yf = y.astype(jnp.float32).reshape(B, T, n_heads, W // n_heads)
    mu = jnp.mean(yf, axis=-1, keepdims=True)
    d = yf - mu
    yf = d * lax.rsqrt(jnp.mean(d * d, axis=-1, keepdims=True) + GN_EPS)
    return (yf.reshape(B, T, W) * w.astype(jnp.float32) + b.astype(jnp.float32)).astype(y.dtype)


def causal_conv(u, buf, w, b):
    T = u.shape[1]
    ext = jnp.concatenate([buf.astype(u.dtype), u], axis=1)
    out = b
    for j in range(CONV_W):
        out = out + ext[:, j:j + T] * w[j]
    return out, ext[:, -(CONV_W - 1):]


def token_shift(p, prev, mu):
    shifted = jnp.concatenate([prev.astype(p.dtype), p[:, :-1]], axis=1)
    return p + mu * (shifted - p), p[:, -1:]


def mlstm_chunkwise(q, k, v, i_pre, logf, C0, n0, m0):
    B, T, H, Dh = q.shape
    L = math.gcd(T, MLSTM_CHUNK)
    NC = T // L
    f32 = lambda a: a.astype(jnp.float32)

    def to_chunks(a):
        return jnp.moveaxis(f32(a).reshape((B, NC, L) + a.shape[2:]), 1, 0)

    xs = tuple(to_chunks(a) for a in (q, k, v, i_pre, logf))
    causal = jnp.tril(jnp.ones((L, L), dtype=bool))[None, :, :, None]

    def step(carry, blk):
        C, n, m = carry
        qb, kb, vb, ib, fb = blk
        bcum = jnp.cumsum(fb, axis=1)
        dlog = bcum[:, :, None, :] - bcum[:, None, :, :] + ib[:, None, :, :]
        dlog = jnp.where(causal, dlog, -jnp.inf)
        inter = bcum + m[:, None, :]
        m_t = jnp.maximum(inter, jnp.max(dlog, axis=2))
        wts = jnp.exp(dlog - m_t[:, :, None, :])
        sc_inter = jnp.exp(inter - m_t)
        qk = jnp.einsum('bthd,bshd->btsh', qb, kb) * wts
        num = jnp.einsum('btsh,bshd->bthd', qk, vb) + sc_inter[..., None] * jnp.einsum('bthk,bhkv->bthv', qb, C)
        den = jnp.sum(qk, axis=2) + sc_inter * jnp.einsum('bthk,bhk->bth', qb, n)
        h = num / jnp.maximum(jnp.abs(den), jnp.exp(-m_t))[..., None]
        b_end = bcum[:, -1]
        g = b_end[:, None, :] - bcum + ib
        m_new = jnp.maximum(b_end + m, jnp.max(g, axis=1))
        ws = jnp.exp(g - m_new[:, None, :])
        dec = jnp.exp(b_end + m - m_new)
        C_new = dec[..., None, None] * C + jnp.einsum('bsh,bshk,bshv->bhkv', ws, kb, vb)
        n_new = dec[..., None] * n + jnp.einsum('bsh,bshk->bhk', ws, kb)
        return (C_new, n_new, m_new), h

    (C, n, m), hc = lax.scan(step, (f32(C0), f32(n0), f32(m0)), xs)
    h = jnp.moveaxis(hc, 0, 1).reshape(B, T, H, Dh)
    return h, C, n, m


def rwkv7_scan(r, w_log, k, v, kk, a, S0):
    def step(S, xs):
        rt, wt, kt, vt, kkt, at = xs
        sa = jnp.einsum('bhvk,bhk->bhv', S, -kkt)
        S = (S * jnp.exp(wt)[:, :, None, :]
             + sa[..., None] * (kkt * at)[:, :, None, :]
             + vt[..., None] * kt[:, :, None, :])
        return S, jnp.einsum('bhvk,bhk->bhv', S, rt)

    xs = tuple(jnp.moveaxis(t, 1, 0) for t in (r, w_log, k, v, kk, a))
    S, ys = lax.scan(step, S0.astype(jnp.float32), xs)
    return jnp.moveaxis(ys, 0, 1), S


def layer_forward(x, C0, n0, m0, conv0, S0, shift0,
                  norm_mix_w, w_in, mlstm_conv_w, mlstm_conv_b, mlstm_i_b, mlstm_f_b, mlstm_norm_w,
                  rw_mu, rw_w0, rw_w_up, rw_a0, rw_a_up, rw_g_up, rw_k_k, rw_k_a, rw_r_k,
                  rw_ln_w, rw_ln_b, w_out, norm_mlp_w, mlp_up, mlp_down):
    B, T, _ = x.shape
    dt = x.dtype
    xn = rms_norm(x, norm_mix_w)
    proj = xn @ w_in
    ml = proj[..., :ML_IN_W]
    rw = proj[..., ML_IN_W:]

    qk_pre = ml[..., :2 * ML_W]
    v_ml = ml[..., 2 * ML_W:3 * ML_W].reshape(B, T, ML_HEADS, HEAD_DIM)
    o_pre = ml[..., 3 * ML_W:4 * ML_W]
    i_pre = ml[..., 4 * ML_W:4 * ML_W + ML_HEADS].astype(jnp.float32) + mlstm_i_b.astype(jnp.float32)
    f_pre = ml[..., 4 * ML_W + ML_HEADS:].astype(jnp.float32) + mlstm_f_b.astype(jnp.float32)
    qk_c, conv_new = causal_conv(qk_pre, conv0, mlstm_conv_w, mlstm_conv_b)
    qk_c = jax.nn.silu(qk_c)
    q_ml = qk_c[..., :ML_W].reshape(B, T, ML_HEADS, HEAD_DIM)
    k_ml = qk_c[..., ML_W:].reshape(B, T, ML_HEADS, HEAD_DIM) * (HEAD_DIM ** -0.5)
    h_til, C_new, n_new, m_new = mlstm_chunkwise(q_ml, k_ml, v_ml, i_pre, jax.nn.log_sigmoid(f_pre), C0, n0, m0)
    h_ml = jax.nn.sigmoid(o_pre) * h_til.reshape(B, T, ML_W).astype(dt)
    h_ml = head_rms_norm(h_ml, mlstm_norm_w, ML_HEADS)

    rs, shift_new = token_shift(rw, shift0, rw_mu)
    r = rs[..., :RW_W]
    kr = rs[..., RW_W:2 * RW_W]
    vr = rs[..., 2 * RW_W:3 * RW_W]
    o = 3 * RW_W
    xw = rs[..., o:o + D_DECAY_LORA]
    o += D_DECAY_LORA
    xa = rs[..., o:o + D_AAA_LORA]
    o += D_AAA_LORA
    xg = rs[..., o:o + D_GATE_LORA]
    w_raw = (rw_w0 + jnp.tanh(xw) @ rw_w_up).astype(jnp.float32)
    w_log = -jnp.exp(-jax.nn.softplus(-w_raw) - 0.5)
    a = jax.nn.sigmoid((rw_a0 + xa @ rw_a_up).astype(jnp.float32))
    g = jax.nn.sigmoid(xg) @ rw_g_up
    kf = kr.astype(jnp.float32)
    kk = (kf * rw_k_k.astype(jnp.float32)).reshape(B, T, RW_HEADS, HEAD_DIM)
    kk = kk / jnp.maximum(jnp.sqrt(jnp.sum(kk * kk, axis=-1, keepdims=True)), 1e-12)
    k_eff = kf * (1.0 + (a - 1.0) * rw_k_a.astype(jnp.float32))
    heads = lambda t: t.astype(jnp.float32).reshape(B, T, RW_HEADS, HEAD_DIM)
    rh, kh, vh, wh, ah = heads(r), heads(k_eff), heads(vr), heads(w_log), heads(a)
    y, S_new = rwkv7_scan(rh, wh, kh, vh, kk, ah, S0)
    bonus = jnp.sum(rh * kh * rw_r_k.astype(jnp.float32), axis=-1, keepdims=True) * vh
    y_rw = (y + bonus).reshape(B, T, RW_W).astype(dt)
    y_rw = head_group_norm(y_rw, rw_ln_w, rw_ln_b, RW_HEADS) * g

    x = x + jnp.concatenate([h_ml, y_rw], axis=-1) @ w_out
    hid = jax.nn.relu(rms_norm(x, norm_mlp_w) @ mlp_up)
    x = x + jnp.square(hid) @ mlp_down
    sd = C0.dtype
    return (x, C_new.astype(sd), n_new.astype(sd), m_new.astype(sd), conv_new.astype(sd),
            S_new.astype(sd), shift_new.astype(sd))


def setup_inputs(seed: int = 0) -> dict:
    key = jax.random.key(seed)
    ks = iter(jax.random.split(key, 48))
    f32 = jnp.float32

    def nrm(shape, s):
        return jax.random.normal(next(ks), shape, f32) * s

    def unif(shape, lo, hi):
        return jax.random.uniform(next(ks), shape, f32, lo, hi)

    Ld = DEPTH
    f_bias = jnp.broadcast_to(jnp.linspace(3.0, 6.0, ML_HEADS, dtype=f32), (Ld, ML_HEADS))
    return {
        "x_prompt": nrm((BATCH, SEQ, D_MODEL), 1.0),
        "x_sample": nrm((DEC_BATCH, DEC_SEQ, D_MODEL), 1.0),
        "state_mlstm_C": nrm((Ld, DEC_BATCH, ML_HEADS, HEAD_DIM, HEAD_DIM), 0.1),
        "state_mlstm_n": nrm((Ld, DEC_BATCH, ML_HEADS, HEAD_DIM), 0.5),
        "state_mlstm_m": nrm((Ld, DEC_BATCH, ML_HEADS), 1.0),
        "state_mlstm_conv": nrm((Ld, DEC_BATCH, CONV_W - 1, 2 * ML_W), 1.0),
        "state_rwkv_S": nrm((Ld, DEC_BATCH, RW_HEADS, HEAD_DIM, HEAD_DIM), 0.2),
        "state_rwkv_shift": nrm((Ld, DEC_BATCH, 1, RW_IN_W), 1.0),
        "norm_mix_w": 1.0 + nrm((Ld, D_MODEL), 0.01),
        "w_in": nrm((Ld, D_MODEL, IN_W), D_MODEL ** -0.5),
        "mlstm_conv_w": nrm((Ld, CONV_W, 2 * ML_W), CONV_W ** -0.5),
        "mlstm_conv_b": nrm((Ld, 2 * ML_W), 0.01),
        "mlstm_i_b": nrm((Ld, ML_HEADS), 0.1),
        "mlstm_f_b": f_bias + nrm((Ld, ML_HEADS), 0.1),
        "mlstm_norm_w": 1.0 + nrm((Ld, ML_W), 0.01),
        "rw_mu": unif((Ld, RW_IN_W), 0.0, 1.0),
        "rw_w0": unif((Ld, RW_W), -6.0, -1.0),
        "rw_w_up": nrm((Ld, D_DECAY_LORA, RW_W), 0.1),
        "rw_a0": nrm((Ld, RW_W), 0.1),
        "rw_a_up": nrm((Ld, D_AAA_LORA, RW_W), 0.1),
        "rw_g_up": nrm((Ld, D_GATE_LORA, RW_W), D_GATE_LORA ** -0.5),
        "rw_k_k": 0.85 + nrm((Ld, RW_W), 0.05),
        "rw_k_a": 1.0 + nrm((Ld, RW_W), 0.05),
        "rw_r_k": nrm((Ld, RW_HEADS, HEAD_DIM), 0.1),
        "rw_ln_w": 1.0 + nrm((Ld, RW_W), 0.01),
        "rw_ln_b": nrm((Ld, RW_W), 0.01),
        "w_out": nrm((Ld, MIX_W, D_MODEL), MIX_W ** -0.5),
        "norm_mlp_w": 1.0 + nrm((Ld, D_MODEL), 0.01),
        "mlp_up": nrm((Ld, D_MODEL, D_FF), D_MODEL ** -0.5),
        "mlp_down": nrm((Ld, D_FF, D_MODEL), D_FF ** -0.5),
        "norm_f_w": 1.0 + nrm((D_MODEL,), 0.01),
    }


def reference(x_prompt, x_sample, state_mlstm_C, state_mlstm_n, state_mlstm_m, state_mlstm_conv,
              state_rwkv_S, state_rwkv_shift, norm_mix_w, w_in, mlstm_conv_w, mlstm_conv_b, mlstm_i_b,
              mlstm_f_b, mlstm_norm_w, rw_mu, rw_w0, rw_w_up, rw_a0, rw_a_up, rw_g_up, rw_k_k, rw_k_a,
              rw_r_k, rw_ln_w, rw_ln_b, w_out, norm_mlp_w, mlp_up, mlp_down, norm_f_w):
    Bp = x_prompt.shape[0]
    sd = state_mlstm_C.dtype
    xp, xs = x_prompt, x_sample
    pC, pn, pm, pconv, pS, pshift = [], [], [], [], [], []
    sC, sn, sm, sconv, sS, sshift = [], [], [], [], [], []
    for l in range(DEPTH):
        wl = (norm_mix_w[l], w_in[l], mlstm_conv_w[l], mlstm_conv_b[l], mlstm_i_b[l], mlstm_f_b[l],
              mlstm_norm_w[l], rw_mu[l], rw_w0[l], rw_w_up[l], rw_a0[l], rw_a_up[l], rw_g_up[l],
              rw_k_k[l], rw_k_a[l], rw_r_k[l], rw_ln_w[l], rw_ln_b[l], w_out[l], norm_mlp_w[l],
              mlp_up[l], mlp_down[l])
        outp = layer_forward(
            xp,
            jnp.zeros((Bp, ML_HEADS, HEAD_DIM, HEAD_DIM), sd),
            jnp.zeros((Bp, ML_HEADS, HEAD_DIM), sd),
            jnp.zeros((Bp, ML_HEADS), sd),
            jnp.zeros((Bp, CONV_W - 1, 2 * ML_W), sd),
            jnp.zeros((Bp, RW_HEADS, HEAD_DIM, HEAD_DIM), sd),
            jnp.zeros((Bp, 1, RW_IN_W), sd),
            *wl)
        xp = outp[0]
        pC.append(outp[1]); pn.append(outp[2]); pm.append(outp[3])
        pconv.append(outp[4]); pS.append(outp[5]); pshift.append(outp[6])
        outs = layer_forward(xs, state_mlstm_C[l], state_mlstm_n[l], state_mlstm_m[l],
                             state_mlstm_conv[l], state_rwkv_S[l], state_rwkv_shift[l], *wl)
        xs = outs[0]
        sC.append(outs[1]); sn.append(outs[2]); sm.append(outs[3])
        sconv.append(outs[4]); sS.append(outs[5]); sshift.append(outs[6])
    y_prompt = rms_norm(xp, norm_f_w)
    y_sample = rms_norm(xs, norm_f_w)
    return (y_prompt, y_sample,
            jnp.stack(pC), jnp.stack(pn), jnp.stack(pm), jnp.stack(pconv), jnp.stack(pS), jnp.stack(pshift),
            jnp.stack(sC), jnp.stack(sn), jnp.stack(sm), jnp.stack(sconv), jnp.stack(sS), jnp.stack(sshift))
```

```cpp
#include <hip/hip_runtime.h>
#include <hip/hip_cooperative_groups.h>
#include <cstdio>
namespace cg = cooperative_groups;

#define LAS __attribute__((address_space(3)))
typedef _Float16 h16;
typedef _Float16 h16x8 __attribute__((ext_vector_type(8)));
typedef _Float16 h16x4 __attribute__((ext_vector_type(4)));
typedef float f32x4 __attribute__((ext_vector_type(4)));
typedef unsigned u32x4 __attribute__((ext_vector_type(4)));

constexpr int D = 1024, MP = 16384, MS = 128, MALL = 16512, MPAD = 16640, SEQ = 2048;
constexpr int NPROJ = 3840;
constexpr int RWW = 1792, DFF = 4096;
constexpr float EPS = 1e-6f, GN_EPS = 64e-5f;
constexpr int LDS_BYTES = 131072;

constexpr size_t OFF_WT_IN = 0;
constexpr size_t OFF_WT_G = OFF_WT_IN + (size_t)NPROJ * D * 2;
constexpr size_t OFF_WT_OUT = OFF_WT_G + 16 * D * 2;
constexpr size_t OFF_WT_UP = OFF_WT_OUT + (size_t)D * D * 2;
constexpr size_t OFF_WT_DN = OFF_WT_UP + (size_t)DFF * D * 2;
constexpr size_t OFF_LW = OFF_WT_DN + (size_t)DFF * D * 2;
constexpr size_t OFF_LA = OFF_LW + 512 * 64 * 2;
constexpr size_t OFF_LG = OFF_LA + 512 * 64 * 2;
constexpr size_t OFF_GATES = OFF_LG + 512 * 128 * 2;
constexpr size_t OFF_SS1 = OFF_GATES + (size_t)MPAD * 16 * 4;
constexpr size_t OFF_SS2 = OFF_SS1 + (size_t)MPAD * 4;
constexpr size_t OFF_RKS = OFF_SS2 + (size_t)MPAD * 4;
constexpr size_t OFF_CNT = OFF_RKS + (size_t)MPAD * 8 * 4;
constexpr size_t OFF_BAR = OFF_CNT + 256;
constexpr size_t OFF_DYN = OFF_BAR + 16384;
constexpr size_t OFF_XN16 = OFF_DYN;
constexpr size_t OFF_OPS16 = OFF_DYN;
constexpr size_t OFF_PROJ16 = 268435456ull - (size_t)MPAD * NPROJ * 2;
constexpr size_t OFF_YRAW = OFF_PROJ16;
constexpr size_t OFF_X1 = OFF_DYN;
constexpr size_t OFF_X116 = OFF_X1 + (size_t)MPAD * D * 4;
constexpr size_t OFF_HID16 = OFF_X116 + (size_t)MPAD * D * 2;
static_assert(OFF_DYN % 256 == 0 && OFF_PROJ16 % 256 == 0, "align");
static_assert(OFF_OPS16 + (size_t)MALL * 8 * 6 * 64 * 2 <= OFF_PROJ16, "ops overlap");
static_assert(OFF_HID16 + (size_t)MPAD * DFF * 2 <= 268435456ull, "ws overflow");
constexpr size_t OUTB_MIX16 = 0, OUTB_G16 = (size_t)MPAD * D * 2;
static_assert(OUTB_G16 + (size_t)MALL * 512 * 2 <= (size_t)MP * D * 4, "out scratch overflow");
constexpr size_t O_YP = 0, O_YS = 16777216, O_PC = 16908288, O_PN = 17170432, O_PM = 17174528, O_PCONV = 17174592, O_PS = 17199168,
                 O_PSH = 17461312, O_SC = 17475648, O_SN = 21669952, O_SM = 21735488, O_SCONV = 21736512, O_SS = 22129728, O_SSH = 26324032;

struct Params { const float* in[31]; float* out; unsigned char* ws; };

__device__ __forceinline__ f32x4 mfma16(h16x8 a, h16x8 b, f32x4 c) { return __builtin_amdgcn_mfma_f32_16x16x32_f16(a, b, c, 0, 0, 0); }
__device__ __forceinline__ float wave_sum(float v) {
#pragma unroll
    for (int o = 1; o < 64; o <<= 1) v += __shfl_xor(v, o);
    return v;
}
__device__ __forceinline__ float wave_max(float v) {
#pragma unroll
    for (int o = 1; o < 64; o <<= 1) v = fmaxf(v, __shfl_xor(v, o));
    return v;
}
__device__ __forceinline__ void lds_barrier() { asm volatile("s_waitcnt lgkmcnt(0)\n\ts_barrier" ::: "memory"); }
#define XB_XCNT(j) (64 * (j))
#define XB_XSUB(j) (1024 + 64 * (j))
#define XB_XGEN(j) (2048 + 64 * (j))
#define XB_TOP 3072
#define XB_TOPGEN 3136
__device__ __forceinline__ unsigned xb_ld(unsigned* p) { return __hip_atomic_load(p, __ATOMIC_RELAXED, __HIP_MEMORY_SCOPE_AGENT); }
__device__ __forceinline__ unsigned xb_add(unsigned* p, unsigned v) { return __hip_atomic_fetch_add(p, v, __ATOMIC_RELAXED, __HIP_MEMORY_SCOPE_AGENT); }
__device__ __forceinline__ unsigned xb_xcc_id() { return (unsigned)__builtin_amdgcn_s_getreg((3 << 11) | 20) & 0xFu; }
struct XB { unsigned* bar; unsigned x, nloc, nx; };
__device__ __forceinline__ void xcd_barrier(const XB& b) {
    __syncthreads();
    if (threadIdx.x == 0) {
        unsigned* bar = b.bar;
        __builtin_amdgcn_fence(__ATOMIC_RELEASE, "agent");
        asm volatile("s_waitcnt vmcnt(0)" ::: "memory");
        const unsigned old = xb_add(&bar[XB_XSUB(b.x)], 1u);
        const unsigned gen = old / b.nloc;
        if (old + 1u == (gen + 1u) * b.nloc) {
            const unsigned og = xb_add(&bar[XB_TOP], 1u);
            const unsigned target = (og / b.nx + 1u) * b.nx;
            if (og + 1u != target) while (xb_ld(&bar[XB_TOP]) < target) __builtin_amdgcn_s_sleep(1);
            xb_add(&bar[XB_XGEN(b.x)], 1u);
        } else {
            while (xb_ld(&bar[XB_XGEN(b.x)]) == gen) __builtin_amdgcn_s_sleep(1);
        }
        __builtin_amdgcn_fence(__ATOMIC_ACQUIRE, "agent");
        asm volatile("s_waitcnt vmcnt(0)" ::: "memory");
    }
    __syncthreads();
}
__device__ __forceinline__ float sigm(float x) { return __builtin_amdgcn_rcpf(1.f + __expf(-x)); }
template <int CTRL> __device__ __forceinline__ float dpp_add(float x) {
    return x + __builtin_bit_cast(float, __builtin_amdgcn_update_dpp(0, __builtin_bit_cast(int, x), CTRL, 0xF, 0xF, true));
}
__device__ __forceinline__ float row_sum16(float x) { x = dpp_add<0xB1>(x); x = dpp_add<0x4E>(x); x = dpp_add<0x124>(x); x = dpp_add<0x128>(x); return x; }

namespace pg8 {
constexpr int BM = 256, BK = 64, HALF = 128, HTB = HALF * BK * 2, NXCD = 8, WGM = 8;
__device__ __forceinline__ int lds_byte(int r, int c) { const int st = (r >> 4) * 2 + (c >> 5), rr = r & 15, cc = c & 31, ob = rr * 64 + cc * 2; return st * 1024 + (ob ^ (((ob >> 9) & 1) << 5)); }
__device__ __forceinline__ void stage_rc(int b, int& R, int& C) { const int st = b / 1024, sb = b % 1024, swz = sb ^ (((sb >> 9) & 1) << 5); R = (st >> 1) * 16 + swz / 64; C = (st & 1) * 32 + (swz % 64) / 2; }
__device__ __forceinline__ int perm32(int rho) { const int n = rho >> 4, i = rho & 15; return 8 * (i >> 2) + 4 * n + (i & 3); }
struct Unit { int pm, pn; };
struct Gemm { const h16* A; const h16* Bt; int M, N, K; };
struct StaticOrder {
    int nM, nN, nwg, G, c;
    __device__ void init(int M, int N, int G_, int c_) { nM = M / BM; nN = N / BM; nwg = nM * nN; G = G_; c = c_; }
    __device__ bool next(int i, Unit& u) const {
        const long L = (long)i * G + c; if (L >= nwg) return false;
        int wgid = (int)L; { const int q = nwg / NXCD, r = nwg % NXCD, xcd = wgid % NXCD, off = wgid / NXCD; wgid = (xcd < r ? xcd * (q + 1) : r * (q + 1) + (xcd - r) * q) + off; }
        const int nig = WGM * nN, gid = wgid / nig, fm = gid * WGM, gsz = (nM - fm) < WGM ? (nM - fm) : WGM;
        u.pm = fm + ((wgid % nig) % gsz); u.pn = (wgid % nig) / gsz; return true;
    }
};

template <class Epi>
__device__ __forceinline__ void gemm_phase(LAS unsigned char* lds, const Gemm g, const StaticOrder& S, const Epi& E) {
    int tid = threadIdx.x;
    asm volatile("" : "+v"(tid));
    const int wid = __builtin_amdgcn_readfirstlane(tid >> 6), lane = tid & 63, wr = wid >> 2, wc = wid & 3, fr = lane & 15, fq = lane >> 4;
    const int K = g.K, nt = K / BK;
    unsigned voffA[2], voffB[2];
#pragma unroll
    for (int i = 0; i < 2; ++i) { int R, C; stage_rc(tid * 16 + i * 8192, R, C); const int Rb = (R & ~31) + perm32(R & 31);
        voffA[i] = (unsigned)(R * K + C) * 2u; voffB[i] = (unsigned)(Rb * K + C) * 2u; }
    const size_t kstep = (size_t)(BK * 2);
    const size_t hstep = (size_t)HALF * K * 2;
    const size_t tstep = 2 * hstep;
    const unsigned ldsw = (unsigned)wid * 1024u;
    const int aoff = lds_byte(wr * 64 + fr, fq * 8), boff = lds_byte(wc * 32 + fr, fq * 8);
#define PG8_SA(b, h) (((b) * 2 + (h)) * HTB)
#define PG8_SB(b, h) ((4 + (b) * 2 + (h)) * HTB)
#define PG8_STAGE(bufoff, gbase, voff) do { _Pragma("unroll") for (int _i = 0; _i < 2; ++_i) \
        __builtin_amdgcn_global_load_lds((const unsigned*)((const char*)(gbase) + (voff)[_i]), (LAS unsigned*)(lds + (bufoff) + ldsw + _i * 8192), 16, 0, 0); } while (0)
#define PG8_LDA(dst, b, h) do { _Pragma("unroll") for (int m = 0; m < 4; ++m) _Pragma("unroll") for (int k = 0; k < 2; ++k) dst[m][k] = *(const LAS h16x8*)(lds + PG8_SA(b, h) + aoff + m * 2048 + k * 1024); } while (0)
#define PG8_LDB(dst, b, h) do { _Pragma("unroll") for (int n = 0; n < 2; ++n) _Pragma("unroll") for (int k = 0; k < 2; ++k) dst[n][k] = *(const LAS h16x8*)(lds + PG8_SB(b, h) + boff + n * 2048 + k * 1024); } while (0)
#define PG8_MMA(ai, bj, At, Bt) do { __builtin_amdgcn_s_setprio(1); _Pragma("unroll") for (int m = 0; m < 4; ++m) _Pragma("unroll") for (int n = 0; n < 2; ++n) _Pragma("unroll") for (int k = 0; k < 2; ++k) \
        acc[ai][bj][m][n] = __builtin_amdgcn_mfma_f32_16x16x32_f16(Bt[n][k], At[m][k], acc[ai][bj][m][n], 0, 0, 0); __builtin_amdgcn_s_setprio(0); } while (0)
#define PG8_WAIT_V(n) asm volatile("s_waitcnt vmcnt(" #n ")" ::: "memory")
#define PG8_WAIT_L(n) asm volatile("s_waitcnt lgkmcnt(" #n ")" ::: "memory")
#define PG8_BAR __builtin_amdgcn_s_barrier()
#define PG8_SCHED __builtin_amdgcn_sched_barrier(0)
    Unit cur, nxt; int ui = 0;
    if (!S.next(0, cur)) return;
    f32x4 acc[2][2][4][2];
#pragma unroll
    for (int a = 0; a < 2; ++a)
#pragma unroll
        for (int b = 0; b < 2; ++b)
#pragma unroll
            for (int m = 0; m < 4; ++m)
#pragma unroll
                for (int n = 0; n < 2; ++n) acc[a][b][m][n] = (f32x4){0.f, 0.f, 0.f, 0.f};
    h16x8 At[4][2], B0[2][2], B1[2][2];
    const char* cA = (const char*)g.A + (size_t)cur.pm * tstep; const char* cB = (const char*)g.Bt + (size_t)cur.pn * tstep;
    PG8_STAGE(PG8_SB(0, 0), cB, voffB); PG8_STAGE(PG8_SA(0, 0), cA, voffA); PG8_STAGE(PG8_SB(0, 1), cB + hstep, voffB); PG8_STAGE(PG8_SA(0, 1), cA + hstep, voffA);
    if (wr == 1) PG8_BAR;
    PG8_WAIT_V(4); PG8_BAR;
    PG8_STAGE(PG8_SB(1, 0), cB + kstep, voffB); PG8_STAGE(PG8_SA(1, 0), cA + kstep, voffA); PG8_STAGE(PG8_SB(1, 1), cB + hstep + kstep, voffB);
    PG8_WAIT_V(6); PG8_BAR;
    for (;;) {
        const bool has_next = S.next(ui + 1, nxt);
        const char* nA = has_next ? (const char*)g.A + (size_t)nxt.pm * tstep : cA; const char* nB = has_next ? (const char*)g.Bt + (size_t)nxt.pn * tstep : cB;
        for (int t = 0; t < nt; t += 2) {
            const bool last = (t == nt - 2);
            const char* a1 = cA + (size_t)(t + 1) * kstep;
            const char* a2 = last ? nA : cA + (size_t)(t + 2) * kstep; const char* b2 = last ? nB : cB + (size_t)(t + 2) * kstep;
            const char* a3 = a2 + kstep; const char* b3 = b2 + kstep;
            PG8_LDB(B0, 0, 0); PG8_SCHED; PG8_LDA(At, 0, 0); PG8_STAGE(PG8_SA(1, 1), a1 + hstep, voffA);
            PG8_WAIT_L(8); PG8_BAR; PG8_WAIT_L(0); PG8_MMA(0, 0, At, B0); PG8_BAR; PG8_SCHED;
            PG8_LDB(B1, 0, 1); PG8_STAGE(PG8_SB(0, 0), b2, voffB);
            PG8_BAR; PG8_WAIT_L(0); PG8_MMA(0, 1, At, B1); PG8_BAR;
            PG8_LDA(At, 0, 1); PG8_STAGE(PG8_SA(0, 0), a2, voffA);
            PG8_BAR; PG8_WAIT_L(0); PG8_MMA(1, 0, At, B0); PG8_BAR; PG8_SCHED;
            PG8_STAGE(PG8_SB(0, 1), b2 + hstep, voffB);
            PG8_WAIT_V(6); PG8_BAR; PG8_MMA(1, 1, At, B1); PG8_BAR;
            PG8_LDB(B0, 1, 0); PG8_SCHED; PG8_LDA(At, 1, 0); PG8_STAGE(PG8_SA(0, 1), a2 + hstep, voffA);
            PG8_WAIT_L(8); PG8_BAR; PG8_WAIT_L(0); PG8_MMA(0, 0, At, B0); PG8_BAR; PG8_SCHED;
            PG8_LDB(B1, 1, 1); PG8_STAGE(PG8_SB(1, 0), b3, voffB);
            PG8_BAR; PG8_WAIT_L(0); PG8_MMA(0, 1, At, B1); PG8_BAR;
            PG8_LDA(At, 1, 1); PG8_STAGE(PG8_SA(1, 0), a3, voffA);
            PG8_BAR; PG8_WAIT_L(0); PG8_MMA(1, 0, At, B0); PG8_BAR; PG8_SCHED;
            PG8_STAGE(PG8_SB(1, 1), b3 + hstep, voffB);
            PG8_WAIT_V(6); PG8_BAR; PG8_MMA(1, 1, At, B1); PG8_BAR;
        }
        if constexpr (!Epi::AFTER_DRAIN) E(acc, cur, wr, wc, fr, fq);
        if (!has_next) break;
#pragma unroll
        for (int a = 0; a < 2; ++a)
#pragma unroll
            for (int b = 0; b < 2; ++b)
#pragma unroll
                for (int m = 0; m < 4; ++m)
#pragma unroll
                    for (int n = 0; n < 2; ++n) acc[a][b][m][n] = (f32x4){0.f, 0.f, 0.f, 0.f};
        cur = nxt; cA = nA; cB = nB; ++ui;
    }
    PG8_WAIT_V(0);
    if (wr == 0) PG8_BAR;
    PG8_BAR;
    if constexpr (Epi::AFTER_DRAIN) E(acc, cur, wr, wc, fr, fq);
#undef PG8_SA
#undef PG8_SB
#undef PG8_STAGE
#undef PG8_LDA
#undef PG8_LDB
#undef PG8_MMA
#undef PG8_WAIT_V
#undef PG8_WAIT_L
#undef PG8_BAR
#undef PG8_SCHED
}
}

__device__ __forceinline__ h16x8 pack8(f32x4 a, f32x4 b) {
    h16x8 o; o[0] = (h16)a[0]; o[1] = (h16)a[1]; o[2] = (h16)a[2]; o[3] = (h16)a[3]; o[4] = (h16)b[0]; o[5] = (h16)b[1]; o[6] = (h16)b[2]; o[7] = (h16)b[3]; return o;
}
__device__ __forceinline__ h16x4 pack4(f32x4 a) { h16x4 o; o[0] = (h16)a[0]; o[1] = (h16)a[1]; o[2] = (h16)a[2]; o[3] = (h16)a[3]; return o; }

template <int MODE> struct Epi {
    static constexpr bool AFTER_DRAIN = false;
    h16* o16; int ld16; float* o32; int ld32; const float* res; int ldres; float* rowss; const h16* res16;
    __device__ __forceinline__ void operator()(const f32x4 (&acc)[2][2][4][2], const pg8::Unit& u, int wr, int wc, int fr, int fq) const {
        const int row0 = u.pm * 256 + wr * 64 + fr, col0 = u.pn * 256 + wc * 32 + 8 * fq;
#pragma unroll
        for (int ai = 0; ai < 2; ++ai)
#pragma unroll
            for (int m = 0; m < 4; ++m) {
                const int row = row0 + ai * 128 + m * 16;
                float ss = 0.f, rstd = 1.f;
                if (MODE == 2) rstd = rsqrtf(rowss[row] * (1.f / 1024.f) + EPS);
#pragma unroll
                for (int bj = 0; bj < 2; ++bj) {
                    const int c = col0 + bj * 128;
                    f32x4 v0 = acc[ai][bj][m][0], v1 = acc[ai][bj][m][1];
                    if (MODE == 1) {
                        const float* rp = res + (size_t)row * ldres + c;
                        v0 += *(const f32x4*)rp; v1 += *(const f32x4*)(rp + 4);
                    }
                    if (MODE == 3) {
                        const h16x8 r8 = *(const h16x8*)(res16 + (size_t)row * ldres + c);
#pragma unroll
                        for (int j = 0; j < 4; ++j) { v0[j] += (float)r8[j]; v1[j] += (float)r8[4 + j]; }
                    }
                    if (MODE == 1 || MODE == 3) {
                        ss += v0[0] * v0[0] + v0[1] * v0[1] + v0[2] * v0[2] + v0[3] * v0[3] + v1[0] * v1[0] + v1[1] * v1[1] + v1[2] * v1[2] + v1[3] * v1[3];
                    }
                    if (MODE == 2) {
#pragma unroll
                        for (int j = 0; j < 4; ++j) { float a = fmaxf(v0[j] * rstd, 0.f), b = fmaxf(v1[j] * rstd, 0.f); v0[j] = a * a; v1[j] = b * b; }
                    }
                    *(h16x8*)(o16 + (size_t)row * ld16 + c) = pack8(v0, v1);
                }
                if (MODE == 1 || MODE == 3) {
                    ss += __shfl_xor(ss, 16); ss += __shfl_xor(ss, 32);
                    if (fq == 0) atomicAdd(rowss + row, ss);
                }
            }
    }
};

struct EpiFinal {
    static constexpr bool AFTER_DRAIN = true;
    float* out; const h16* res16; float* rowss; unsigned* cnt; const float* nw;
    __device__ __forceinline__ void operator()(f32x4 (&acc)[2][2][4][2], const pg8::Unit& u, int wr, int wc, int fr, int fq) const {
        const int row0 = u.pm * 256 + wr * 64 + fr, col0 = u.pn * 256 + wc * 32 + 8 * fq;
#pragma unroll
        for (int ai = 0; ai < 2; ++ai)
#pragma unroll
            for (int m = 0; m < 4; ++m) {
                const int row = row0 + ai * 128 + m * 16;
                float ss = 0.f;
#pragma unroll
                for (int bj = 0; bj < 2; ++bj) {
                    const int c = col0 + bj * 128;
                    const h16x8 r8 = *(const h16x8*)(res16 + (size_t)row * D + c);
                    f32x4 v0 = acc[ai][bj][m][0], v1 = acc[ai][bj][m][1];
#pragma unroll
                    for (int j = 0; j < 4; ++j) { v0[j] += (float)r8[j]; v1[j] += (float)r8[4 + j]; }
                    acc[ai][bj][m][0] = v0; acc[ai][bj][m][1] = v1;
                    ss += v0[0] * v0[0] + v0[1] * v0[1] + v0[2] * v0[2] + v0[3] * v0[3] + v1[0] * v1[0] + v1[1] * v1[1] + v1[2] * v1[2] + v1[3] * v1[3];
                }
                ss += __shfl_xor(ss, 16); ss += __shfl_xor(ss, 32);
                if (fq == 0) atomicAdd(rowss + row, ss);
            }
        asm volatile("s_waitcnt vmcnt(0)" ::: "memory");
        __syncthreads();
        if (threadIdx.x == 0) {
            __hip_atomic_fetch_add(cnt + u.pm, 1u, __ATOMIC_RELAXED, __HIP_MEMORY_SCOPE_AGENT);
            unsigned spins = 0;
            while (__hip_atomic_load(cnt + u.pm, __ATOMIC_RELAXED, __HIP_MEMORY_SCOPE_AGENT) < 4u && ++spins < (1u << 20)) __builtin_amdgcn_s_sleep(1);
        }
        __syncthreads();
#pragma unroll
        for (int ai = 0; ai < 2; ++ai)
#pragma unroll
            for (int m = 0; m < 4; ++m) {
                const int row = row0 + ai * 128 + m * 16;
                const float rstd = rsqrtf(__hip_atomic_load(rowss + row, __ATOMIC_RELAXED, __HIP_MEMORY_SCOPE_AGENT) * (1.f / 1024.f) + EPS);
#pragma unroll
                for (int bj = 0; bj < 2; ++bj) {
                    const int c = col0 + bj * 128;
                    const f32x4 w0 = *(const f32x4*)(nw + c), w1 = *(const f32x4*)(nw + c + 4);
                    float* op = out + (size_t)row * D + c;
                    *(f32x4*)op = acc[ai][bj][m][0] * rstd * w0; *(f32x4*)(op + 4) = acc[ai][bj][m][1] * rstd * w1;
                }
            }
    }
};

enum { SK_GATES = 0, SK_OUT = 1, SK_UP = 2, SK_DOWN = 3 };
template <int MODE>
__device__ __forceinline__ void skinny(const Params& p, const h16* A, int lda, int row0, int nrt, const h16* Bt, int K, int nct) {
    const int lane = threadIdx.x & 63, wave = threadIdx.x >> 6, fr = lane & 15, fq = lane >> 4;
    const int gw = blockIdx.x * 8 + wave, ngw = gridDim.x * 8;
    unsigned char* ws = p.ws;
    for (int task = gw; task < nrt * nct; task += ngw) {
        const int rt = task % nrt, ct = task / nrt;
        const h16* ap = A + (size_t)(row0 + rt * 16 + fr) * lda + fq * 8;
        const h16* bp = Bt + (size_t)(ct * 16 + fr) * K + fq * 8;
        f32x4 acc = {0.f, 0.f, 0.f, 0.f};
#pragma unroll 8
        for (int k = 0; k < K; k += 32) { const h16x8 a = *(const h16x8*)(ap + k); const h16x8 b = *(const h16x8*)(bp + k); acc = mfma16(b, a, acc); }
        const int row = row0 + rt * 16 + fr, col = ct * 16 + fq * 4;
        if (MODE == SK_GATES) {
            const float* bi = p.in[12]; const float* bf = p.in[13];
            f32x4 o;
#pragma unroll
            for (int r = 0; r < 4; ++r) { const int cc = col + r; o[r] = acc[r] + (cc < 8 ? bi[cc] : bf[cc - 8]); }
            *(f32x4*)((float*)(ws + OFF_GATES) + (size_t)row * 16 + col) = o;
        } else if (MODE == SK_OUT) {
            const int s = row - MP;
            f32x4 v = acc + *(const f32x4*)(p.in[1] + (size_t)s * D + col);
            *(f32x4*)((float*)(ws + OFF_X1) + (size_t)row * D + col) = v;
            *(h16x4*)((h16*)(ws + OFF_X116) + (size_t)row * D + col) = pack4(v);
            float ss = v[0] * v[0] + v[1] * v[1] + v[2] * v[2] + v[3] * v[3];
            ss += __shfl_xor(ss, 16); ss += __shfl_xor(ss, 32);
            if (fq == 0) atomicAdd((float*)(ws + OFF_SS1) + row, ss);
        } else if (MODE == SK_UP) {
            const float rstd = rsqrtf(((const float*)(ws + OFF_SS1))[row] * (1.f / 1024.f) + EPS);
            f32x4 v;
#pragma unroll
            for (int r = 0; r < 4; ++r) { const float a = fmaxf(acc[r] * rstd, 0.f); v[r] = a * a; }
            *(h16x4*)((h16*)(ws + OFF_HID16) + (size_t)row * DFF + col) = pack4(v);
        } else {
            const int s = row - MP;
            f32x4 v = acc + *(const f32x4*)((const float*)(ws + OFF_X1) + (size_t)row * D + col);
            *(f32x4*)(p.out + O_YS + (size_t)s * D + col) = v;
            float ss = v[0] * v[0] + v[1] * v[1] + v[2] * v[2] + v[3] * v[3];
            ss += __shfl_xor(ss, 16); ss += __shfl_xor(ss, 32);
            if (fq == 0) atomicAdd((float*)(ws + OFF_SS2) + row, ss);
        }
    }
}

__device__ __forceinline__ void skinny_down_splitk(const Params& p, LAS unsigned char* lds) {
    unsigned char* ws = p.ws;
    LAS float* RED = (LAS float*)lds;
    const int lane = threadIdx.x & 63, wave = threadIdx.x >> 6, fr = lane & 15, fq = lane >> 4, grp = wave >> 2, ksp = wave & 3;
    const h16* A = (const h16*)(ws + OFF_HID16); const h16* Bt = (const h16*)(ws + OFF_WT_DN);
    constexpr int NRT = MS / 16, NCT = D / 16;
    for (int t0 = blockIdx.x * 2; t0 < NRT * NCT; t0 += gridDim.x * 2) {
        const int task = t0 + grp;
        const bool act = task < NRT * NCT;
        const int rt = act ? task % NRT : 0, ct = act ? task / NRT : 0;
        const h16* ap = A + (size_t)(MP + rt * 16 + fr) * DFF + ksp * 1024 + fq * 8;
        const h16* bp = Bt + (size_t)(ct * 16 + fr) * DFF + ksp * 1024 + fq * 8;
        f32x4 acc = {0.f, 0.f, 0.f, 0.f};
#pragma unroll 8
        for (int k = 0; k < 1024; k += 32) { const h16x8 a = *(const h16x8*)(ap + k); const h16x8 b = *(const h16x8*)(bp + k); acc = mfma16(b, a, acc); }
        *(LAS f32x4*)(RED + ((grp * 4 + ksp) * 64 + lane) * 4) = acc;
        __syncthreads();
        if (ksp == 0 && act) {
#pragma unroll
            for (int q = 1; q < 4; ++q) acc += *(const LAS f32x4*)(RED + ((grp * 4 + q) * 64 + lane) * 4);
            const int row = MP + rt * 16 + fr, col = ct * 16 + fq * 4, sidx = row - MP;
            f32x4 v = acc + *(const f32x4*)((const float*)(ws + OFF_X1) + (size_t)row * D + col);
            *(f32x4*)(p.out + O_YS + (size_t)sidx * D + col) = v;
            float ss = v[0] * v[0] + v[1] * v[1] + v[2] * v[2] + v[3] * v[3];
            ss += __shfl_xor(ss, 16); ss += __shfl_xor(ss, 32);
            if (fq == 0) atomicAdd((float*)(ws + OFF_SS2) + row, ss);
        }
        __syncthreads();
    }
}

__device__ __forceinline__ void tr_tile(const float* W, int K, int N, int kt, int nt, LAS float* tile, const float* kscale, h16* dst, int mode, h16* dstG) {
    const int tid = threadIdx.x, k0 = kt * 64, n0 = nt * 64;
    {
        const int kr = tid >> 4, nc = (tid & 15) * 4;
#pragma unroll
        for (int i = 0; i < 2; ++i) {
            const int k = kr + 32 * i;
            f32x4 v = {0.f, 0.f, 0.f, 0.f};
            if (n0 + nc < N) v = *(const f32x4*)(W + (size_t)(k0 + k) * N + n0 + nc);
            const float s = kscale ? kscale[k0 + k] : 1.f;
            tile[k * 65 + nc] = v[0] * s; tile[k * 65 + nc + 1] = v[1] * s; tile[k * 65 + nc + 2] = v[2] * s; tile[k * 65 + nc + 3] = v[3] * s;
        }
    }
    __syncthreads();
    {
        const int n = tid >> 3, kc = (tid & 7) * 8, gn = n0 + n;
        if (gn < N) {
            h16x8 o;
#pragma unroll
            for (int j = 0; j < 8; ++j) o[j] = (h16)tile[(kc + j) * 65 + n];
            h16* d;
            if (mode == 0) d = dst + (size_t)gn * K;
            else d = (gn < 2048) ? dst + (size_t)gn * K : (gn < 2064 ? dstG + (size_t)(gn - 2048) * K : dst + (size_t)(gn - 16) * K);
            *(h16x8*)(d + k0 + kc) = o;
        }
    }
    __syncthreads();
}

__device__ __forceinline__ void p0_prep(const Params& p, LAS unsigned char* lds) {
    unsigned char* ws = p.ws;
    LAS float* tile = (LAS float*)lds;
    for (int i = blockIdx.x * 512 + threadIdx.x; i < (MPAD - MALL) * D / 8; i += gridDim.x * 512) ((u32x4*)(ws + OFF_XN16 + (size_t)MALL * D * 2))[i] = (u32x4){0u, 0u, 0u, 0u};
    for (int i = blockIdx.x * 512 + threadIdx.x; i < 2 * MPAD; i += gridDim.x * 512) ((float*)(ws + OFF_SS1))[i] = 0.f;
    if (blockIdx.x == 0 && threadIdx.x < 64) ((unsigned*)(ws + OFF_CNT))[threadIdx.x] = 0u;
    constexpr int I_IN = 16 * 61, I_LW = 8, I_LA = 8, I_LG = 16;
    constexpr int NIT = I_IN + I_LW + I_LA + I_LG;
    for (int it = blockIdx.x; it < NIT; it += gridDim.x) {
        int r = it;
        if (r < I_IN) { tr_tile(p.in[9], 1024, 3856, r / 61, r % 61, tile, nullptr, (h16*)(ws + OFF_WT_IN), 1, (h16*)(ws + OFF_WT_G)); continue; } r -= I_IN;
        if (r < I_LW) { tr_tile(p.in[17], 64, 512, 0, r, tile, nullptr, (h16*)(ws + OFF_LW), 0, nullptr); continue; } r -= I_LW;
        if (r < I_LA) { tr_tile(p.in[19], 64, 512, 0, r, tile, nullptr, (h16*)(ws + OFF_LA), 0, nullptr); continue; } r -= I_LA;
        tr_tile(p.in[20], 128, 512, r / 8, r % 8, tile, nullptr, (h16*)(ws + OFF_LG), 0, nullptr);
    }
    const int lane = threadIdx.x & 63, wave = threadIdx.x >> 6;
    const float* nw = p.in[8];
    {
        f32x4 w4[4];
#pragma unroll
        for (int j = 0; j < 4; ++j) w4[j] = *(const f32x4*)(nw + lane * 4 + 256 * j);
        const int stride = gridDim.x * 8;
        for (int row = blockIdx.x * 8 + wave; row < MALL; row += 4 * stride) {
            f32x4 v[4][4]; float sq[4];
#pragma unroll
            for (int u = 0; u < 4; ++u) {
                const int r = row + u * stride, rc = r < MALL ? r : row;
                const float* xr = (rc < MP) ? p.in[0] + (size_t)rc * D : p.in[1] + (size_t)(rc - MP) * D;
                sq[u] = 0.f;
#pragma unroll
                for (int j = 0; j < 4; ++j) v[u][j] = *(const f32x4*)(xr + lane * 4 + 256 * j);
            }
#pragma unroll
            for (int u = 0; u < 4; ++u) {
#pragma unroll
                for (int j = 0; j < 4; ++j) sq[u] += v[u][j][0] * v[u][j][0] + v[u][j][1] * v[u][j][1] + v[u][j][2] * v[u][j][2] + v[u][j][3] * v[u][j][3];
                const float rstd = rsqrtf(wave_sum(sq[u]) * (1.f / D) + EPS);
                const int r = row + u * stride;
                if (r < MALL) {
                    h16* o = (h16*)(ws + OFF_XN16) + (size_t)r * D;
#pragma unroll
                    for (int j = 0; j < 4; ++j) *(h16x4*)(o + lane * 4 + 256 * j) = pack4(v[u][j] * rstd * w4[j]);
                }
            }
        }
    }
}

__device__ __forceinline__ float softplusf_(float z) { return fmaxf(z, 0.f) + __logf(1.f + __expf(-fabsf(z))); }
__device__ __forceinline__ void rwkv_prep_tile(const Params& p, LAS unsigned char* lds, int tile) {
    unsigned char* ws = p.ws;
    LAS h16* RS = (LAS h16*)lds;
    const int tid = threadIdx.x, lane = tid & 63, wave = tid >> 6, fr = lane & 15, fq = lane >> 4;
    const h16* PROJ = (const h16*)(ws + OFF_PROJ16);
    const float* mu = p.in[15];
    const int row0 = tile * 32;
    const int h = wave;
    const h16* LW = (const h16*)(ws + OFF_LW); const h16* LA = (const h16*)(ws + OFF_LA); const h16* LG = (const h16*)(ws + OFF_LG);
    auto finish_item = [&](const h16x8 cur, const float (&prev)[8], const f32x4 m0, const f32x4 m1, int i, int row, int c) {
        h16x8 o;
        const bool is_tanh = (c >= 1536 && c < 1600), is_sig = (c >= 1664);
        const float act_scale = is_tanh ? 2.f : 1.f;
#pragma unroll
        for (int j = 0; j < 8; ++j) {
            const float pj = (float)cur[j], mj = j < 4 ? m0[j] : m1[j - 4];
            float rs = pj + mj * (prev[j] - pj);
            const float sg = sigm(act_scale * rs);
            rs = is_tanh ? 2.f * sg - 1.f : (is_sig ? sg : rs);
            o[j] = (h16)rs;
        }
        *(LAS h16x8*)(RS + i * 1800 + c) = o;
        float* so = nullptr;
        if (row < MP) { if ((row & (SEQ - 1)) == SEQ - 1) so = p.out + O_PSH + (size_t)(row >> 11) * RWW + c; }
        else so = p.out + O_SSH + (size_t)(row - MP) * RWW + c;
        if (so) {
            f32x4 a, b;
#pragma unroll
            for (int j = 0; j < 4; ++j) { a[j] = (float)cur[j]; b[j] = (float)cur[4 + j]; }
            *(f32x4*)so = a; *(f32x4*)(so + 4) = b;
        }
    };
    if (row0 < MP) {
#pragma unroll 1
        for (int half = 0; half < 4; ++half) {
            h16x8 cur[4], pv[4];
#pragma unroll
            for (int k = 0; k < 4; ++k) {
                const int kk = (half * 4 + k) < 14 ? (half * 4 + k) : 13;
                const int it = tid + 512 * kk, i = it / 224, g = it - i * 224, row = row0 + i, c = g * 8;
                const int prow = (row & (SEQ - 1)) ? row - 1 : row;
                cur[k] = *(const h16x8*)(PROJ + (size_t)row * NPROJ + 2048 + c);
                pv[k] = *(const h16x8*)(PROJ + (size_t)prow * NPROJ + 2048 + c);
            }
#pragma unroll
            for (int k = 0; k < 4; ++k) {
                if (half * 4 + k >= 14) break;
                const int it = tid + 512 * (half * 4 + k), i = it / 224, g = it - i * 224, row = row0 + i, c = g * 8;
                const bool first = (row & (SEQ - 1)) == 0;
                float prev[8];
#pragma unroll
                for (int j = 0; j < 8; ++j) prev[j] = first ? 0.f : (float)pv[k][j];
                finish_item(cur[k], prev, *(const f32x4*)(mu + c), *(const f32x4*)(mu + c + 4), i, row, c);
            }
        }
    } else {
        for (int it = tid; it < 32 * 224; it += 512) {
            const int i = it / 224, g = it % 224, row = row0 + i, c = g * 8;
            const h16x8 cur = *(const h16x8*)(PROJ + (size_t)row * NPROJ + 2048 + c);
            float prev[8];
            const float* sh = p.in[7] + (size_t)(row - MP) * RWW + c;
            const f32x4 a = *(const f32x4*)sh, b = *(const f32x4*)(sh + 4);
#pragma unroll
            for (int j = 0; j < 4; ++j) { prev[j] = a[j]; prev[4 + j] = b[j]; }
            finish_item(cur, prev, *(const f32x4*)(mu + c), *(const f32x4*)(mu + c + 4), i, row, c);
        }
    }
    __syncthreads();
    f32x4 accW[2][4], accA[2][4], accG[2][4];
#pragma unroll
    for (int rt = 0; rt < 2; ++rt)
#pragma unroll
        for (int ct = 0; ct < 4; ++ct) { accW[rt][ct] = (f32x4){0.f, 0.f, 0.f, 0.f}; accA[rt][ct] = accW[rt][ct]; accG[rt][ct] = accW[rt][ct]; }
#pragma unroll
    for (int ks = 0; ks < 2; ++ks) {
        h16x8 aw[2], aa[2];
#pragma unroll
        for (int rt = 0; rt < 2; ++rt) { aw[rt] = *(const LAS h16x8*)(RS + (rt * 16 + fr) * 1800 + 1536 + ks * 32 + fq * 8); aa[rt] = *(const LAS h16x8*)(RS + (rt * 16 + fr) * 1800 + 1600 + ks * 32 + fq * 8); }
        h16x8 bw[4], ba[4];
#pragma unroll
        for (int ct = 0; ct < 4; ++ct) {
            bw[ct] = *(const h16x8*)(LW + (size_t)(h * 64 + ct * 16 + fr) * 64 + ks * 32 + fq * 8);
            ba[ct] = *(const h16x8*)(LA + (size_t)(h * 64 + ct * 16 + fr) * 64 + ks * 32 + fq * 8);
        }
#pragma unroll
        for (int ct = 0; ct < 4; ++ct)
#pragma unroll
            for (int rt = 0; rt < 2; ++rt) { accW[rt][ct] = mfma16(bw[ct], aw[rt], accW[rt][ct]); accA[rt][ct] = mfma16(ba[ct], aa[rt], accA[rt][ct]); }
    }
#pragma unroll
    for (int ks = 0; ks < 4; ++ks) {
        h16x8 ag[2];
#pragma unroll
        for (int rt = 0; rt < 2; ++rt) ag[rt] = *(const LAS h16x8*)(RS + (rt * 16 + fr) * 1800 + 1664 + ks * 32 + fq * 8);
        h16x8 bg[4];
#pragma unroll
        for (int ct = 0; ct < 4; ++ct) bg[ct] = *(const h16x8*)(LG + (size_t)(h * 64 + ct * 16 + fr) * 128 + ks * 32 + fq * 8);
#pragma unroll
        for (int ct = 0; ct < 4; ++ct)
#pragma unroll
            for (int rt = 0; rt < 2; ++rt) accG[rt][ct] = mfma16(bg[ct], ag[rt], accG[rt][ct]);
    }
    h16* OPS = (h16*)(ws + OFF_OPS16);
    h16* G16 = (h16*)((unsigned char*)p.out + OUTB_G16);
    float* RKS = (float*)(ws + OFF_RKS);
    float ss[2] = {0.f, 0.f}, rks[2] = {0.f, 0.f}, inv[2];
#pragma unroll
    for (int ct = 0; ct < 4; ++ct) {
        const int col = h * 64 + ct * 16 + fq * 4;
        const f32x4 kkw = *(const f32x4*)(p.in[21] + col);
#pragma unroll
        for (int rt = 0; rt < 2; ++rt) {
            const h16x4 k4 = *(const LAS h16x4*)(RS + (rt * 16 + fr) * 1800 + 512 + col);
#pragma unroll
            for (int r = 0; r < 4; ++r) { const float kk = (float)k4[r] * kkw[r]; ss[rt] += kk * kk; }
        }
    }
#pragma unroll
    for (int rt = 0; rt < 2; ++rt) {
        float s1 = ss[rt];
        s1 += __shfl_xor(s1, 16); s1 += __shfl_xor(s1, 32);
        inv[rt] = 1.f / fmaxf(sqrtf(s1), 1e-12f);
    }
#pragma unroll
    for (int ct = 0; ct < 4; ++ct) {
        const int c64 = ct * 16 + fq * 4, col = h * 64 + c64;
        const f32x4 w0 = *(const f32x4*)(p.in[16] + col), a0 = *(const f32x4*)(p.in[18] + col), kkw = *(const f32x4*)(p.in[21] + col),
                    kaw = *(const f32x4*)(p.in[22] + col), rkw = *(const f32x4*)(p.in[23] + col);
#pragma unroll
        for (int rt = 0; rt < 2; ++rt) {
            const int i = rt * 16 + fr, row = row0 + i;
            h16* ob = OPS + ((size_t)row * 8 + h) * 6 * 64;
            const h16x4 r4 = *(const LAS h16x4*)(RS + i * 1800 + col);
            const h16x4 k4 = *(const LAS h16x4*)(RS + i * 1800 + 512 + col);
            const h16x4 v4 = *(const LAS h16x4*)(RS + i * 1800 + 1024 + col);
            f32x4 wl, ke, na, nb;
#pragma unroll
            for (int r = 0; r < 4; ++r) {
                const float wraw = w0[r] + accW[rt][ct][r];
                wl[r] = -__expf(-softplusf_(-wraw) - 0.5f);
                const float a = sigm(a0[r] + accA[rt][ct][r]);
                const float kf = (float)k4[r], kn = kf * kkw[r] * inv[rt];
                na[r] = -kn; nb[r] = kn * a;
                ke[r] = kf * (1.f + (a - 1.f) * kaw[r]);
                rks[rt] += (float)r4[r] * ke[r] * rkw[r];
            }
            *(h16x4*)(ob + 0 * 64 + c64) = r4;
            *(h16x4*)(ob + 1 * 64 + c64) = pack4(wl);
            *(h16x4*)(ob + 2 * 64 + c64) = pack4(ke);
            *(h16x4*)(ob + 3 * 64 + c64) = v4;
            *(h16x4*)(ob + 4 * 64 + c64) = pack4(na);
            *(h16x4*)(ob + 5 * 64 + c64) = pack4(nb);
            *(h16x4*)(G16 + (size_t)row * 512 + col) = pack4(accG[rt][ct]);
        }
        __builtin_amdgcn_sched_barrier(0);
    }
#pragma unroll
    for (int rt = 0; rt < 2; ++rt) {
        const int row = row0 + rt * 16 + fr;
        float s2 = rks[rt];
        s2 += __shfl_xor(s2, 16); s2 += __shfl_xor(s2, 32);
        if (fq == 0) RKS[(size_t)row * 8 + h] = s2;
    }
    __syncthreads();
}

struct MlChain { int rowbase, T, h; const float* C0; const float* n0; const float* m0; const float* conv0; float* Cout; float* nout; float* mout; float* convout; };
typedef _Float16 h16x2 __attribute__((ext_vector_type(2)));
__device__ __forceinline__ void mlstm_chain(const Params& p, LAS unsigned char* lds, const MlChain ch) {
    unsigned char* ws = p.ws;
    LAS h16* XQ = (LAS h16*)lds;
    LAS h16* QS = (LAS h16*)(lds + 18432);
    LAS h16* KS = QS + 64 * 72; LAS h16* VT = KS + 64 * 72; LAS h16* KW = VT + 64 * 72; LAS h16* PP = KW + 64 * 72; LAS h16* CT = PP + 64 * 72;
    LAS float* SCL = (LAS float*)(lds + 73728);
    LAS float* DEN = SCL; LAS float* SSQ = SCL + 128; LAS float* NL = SCL + 256; LAS float* DQN = SCL + 320;
    LAS float* CBC = (LAS float*)(lds + 75264); LAS float* CUU = CBC + 2048; LAS float* CCM = CUU + 2048; LAS float* CBE = CCM + 2048; LAS float* CGM = CBE + 32;
    const int tid = threadIdx.x, lane = tid & 63, wave = tid >> 6, fr = lane & 15, fq = lane >> 4;
    const int h = ch.h, T = ch.T, rowbase = ch.rowbase;
    const h16* PROJ = (const h16*)(ws + OFF_PROJ16);
    const float* GATES = (const float*)(ws + OFF_GATES);
    h16* MIX = (h16*)((unsigned char*)p.out + OUTB_MIX16);
    const int kt = wave & 3;
    f32x4 Cacc[2];
#pragma unroll
    for (int j = 0; j < 2; ++j) {
        const int vt = (wave >> 2) * 2 + j;
#pragma unroll
        for (int r = 0; r < 4; ++r) Cacc[j][r] = ch.C0 ? ch.C0[(size_t)(kt * 16 + fq * 4 + r) * 64 + vt * 16 + fr] : 0.f;
    }
    const float n0v = (tid < 64 && ch.n0) ? ch.n0[tid] : 0.f;
    float mcur = ch.m0 ? ch.m0[0] : 0.f;
    const int cg8 = tid & 15, gcol0 = (cg8 < 8) ? h * 64 + cg8 * 8 : 512 + h * 64 + (cg8 - 8) * 8;
    float cw[4][8], cbv[8];
#pragma unroll
    for (int j = 0; j < 4; ++j) {
        const f32x4 w0 = *(const f32x4*)(p.in[10] + j * 1024 + gcol0), w1 = *(const f32x4*)(p.in[10] + j * 1024 + gcol0 + 4);
#pragma unroll
        for (int e = 0; e < 4; ++e) { cw[j][e] = w0[e]; cw[j][4 + e] = w1[e]; }
    }
    {
        const f32x4 b0 = *(const f32x4*)(p.in[11] + gcol0), b1 = *(const f32x4*)(p.in[11] + gcol0 + 4);
#pragma unroll
        for (int e = 0; e < 4; ++e) { cbv[e] = b0[e]; cbv[4 + e] = b1[e]; }
    }
    const int nchunks = (T + 63) >> 6;
    for (int cc = wave; cc < nchunks; cc += 8) {
        const int tok = cc * 64 + lane;
        float ig = -INFINITY, lf = 0.f;
        if (tok < T) { const float* gp = GATES + (size_t)(rowbase + tok) * 16; ig = gp[h]; const float f = gp[8 + h]; lf = fminf(f, 0.f) - log1pf(__expf(-fabsf(f))); }
        float bc = lf;
#pragma unroll
        for (int o = 1; o < 64; o <<= 1) { const float t = __shfl_up(bc, o); if (lane >= o) bc += t; }
        const float u = ig - bc;
        float cm = u;
#pragma unroll
        for (int o = 1; o < 64; o <<= 1) { const float t = __shfl_up(cm, o); if (lane >= o) cm = fmaxf(cm, t); }
        const float bend = __shfl(bc, 63);
        const float gmax = wave_max(bend + u);
        CBC[cc * 64 + lane] = bc; CUU[cc * 64 + lane] = u; CCM[cc * 64 + lane] = cm;
        if (lane == 0) { CBE[cc] = bend; CGM[cc] = gmax; }
    }
    h16x8 pxq[3], pvv; h16x4 po[2];
    auto issue_loads = [&](int c) {
        const int t0 = c * 64, nv = (T - t0) < 64 ? (T - t0) : 64;
#pragma unroll
        for (int k = 0; k < 3; ++k) {
            const int it = tid + 512 * k;
            h16x8 v;
#pragma unroll
            for (int j = 0; j < 8; ++j) v[j] = (h16)0.f;
            if (it < 67 * 16) {
                const int i = it >> 4, g = it & 15, tok = t0 - 3 + i, c8 = g * 8;
                const int srccol = (g < 8) ? h * 64 + c8 : 512 + h * 64 + (c8 - 64);
                if (tok >= 0 && tok < T) v = *(const h16x8*)(PROJ + (size_t)(rowbase + tok) * NPROJ + srccol);
                else if (tok < 0 && ch.conv0) {
                    const float* cp = ch.conv0 + (size_t)(3 + tok) * 1024 + srccol;
#pragma unroll
                    for (int j = 0; j < 8; ++j) v[j] = (h16)cp[j];
                }
            }
            pxq[k] = v;
        }
        {
            const int s = tid & 63, g = tid >> 6;
            h16x8 v;
#pragma unroll
            for (int j = 0; j < 8; ++j) v[j] = (h16)0.f;
            if (s < nv) v = *(const h16x8*)(PROJ + (size_t)(rowbase + t0 + s) * NPROJ + 1024 + h * 64 + g * 8);
            pvv = v;
        }
        {
            const int t = (wave & 3) * 16 + fr;
#pragma unroll
            for (int j = 0; j < 2; ++j) {
                h16x4 o4;
#pragma unroll
                for (int r = 0; r < 4; ++r) o4[r] = (h16)0.f;
                if (t < nv) o4 = *(const h16x4*)(PROJ + (size_t)(rowbase + t0 + t) * NPROJ + 1536 + h * 64 + ((wave >> 2) * 2 + j) * 16 + fq * 4);
                po[j] = o4;
            }
        }
    };
    issue_loads(0);
#pragma unroll
    for (int j = 0; j < 2; ++j) *(LAS h16x4*)(CT + (((wave >> 2) * 2 + j) * 16 + fr) * 72 + kt * 16 + fq * 4) = pack4(Cacc[j]);
    if (tid < 64) NL[tid] = n0v;
    __syncthreads();
    for (int c = 0; c < nchunks; ++c) {
        const int t0 = c * 64, nv = (T - t0) < 64 ? (T - t0) : 64;
#pragma unroll
        for (int k = 0; k < 3; ++k) {
            const int it = tid + 512 * k;
            if (it < 67 * 16) *(LAS h16x8*)(XQ + (it >> 4) * 136 + (it & 15) * 8) = pxq[k];
        }
        {
            const int s = tid & 63, g = tid >> 6;
#pragma unroll
            for (int j = 0; j < 8; ++j) VT[(g * 8 + j) * 72 + s] = pvv[j];
        }
        const h16x4 oc0 = po[0], oc1 = po[1];
        const float bendc = CBE[c], mnew = fmaxf(bendc + mcur, CGM[c]), dec = __expf(bendc + mcur - mnew);
        lds_barrier();
        if (c + 1 < nchunks) issue_loads(c + 1);
        {
            const int s0 = (tid >> 4) * 2;
            h16x8 x[5];
#pragma unroll
            for (int j = 0; j < 5; ++j) x[j] = *(const LAS h16x8*)(XQ + (s0 + j) * 136 + cg8 * 8);
            float kw[2][8];
#pragma unroll
            for (int tk = 0; tk < 2; ++tk) {
                const int s = s0 + tk;
                h16x8 yo;
                float wsv = 0.f;
                if (cg8 >= 8) wsv = 0.125f * __expf(bendc + CUU[c * 64 + s] - mnew);
#pragma unroll
                for (int e = 0; e < 8; ++e) {
                    const float a = cbv[e] + (float)x[tk][e] * cw[0][e] + (float)x[tk + 1][e] * cw[1][e] + (float)x[tk + 2][e] * cw[2][e] + (float)x[tk + 3][e] * cw[3][e];
                    const float y = a * __builtin_amdgcn_rcpf(1.f + __expf(-a));
                    yo[e] = (h16)(cg8 < 8 ? y : 0.125f * y);
                    kw[tk][e] = y * wsv;
                }
                if (cg8 < 8) *(LAS h16x8*)(QS + s * 72 + cg8 * 8) = yo;
                else *(LAS h16x8*)(KS + s * 72 + (cg8 - 8) * 8) = yo;
            }
            if (cg8 >= 8) {
#pragma unroll
                for (int e = 0; e < 8; ++e) { h16x2 w2; w2[0] = (h16)kw[0][e]; w2[1] = (h16)kw[1][e]; *(LAS h16x2*)(KW + ((cg8 - 8) * 8 + e) * 72 + s0) = w2; }
            }
        }
        lds_barrier();
        {
            const int tt = wave & 3, sp = wave >> 2;
            h16x8 qa[2];
#pragma unroll
            for (int ks = 0; ks < 2; ++ks) qa[ks] = *(const LAS h16x8*)(QS + (tt * 16 + fr) * 72 + ks * 32 + fq * 8);
            float mx[4];
#pragma unroll
            for (int r = 0; r < 4; ++r) mx[r] = fmaxf(mcur, CCM[c * 64 + tt * 16 + fq * 4 + r]);
            float dpart[4] = {0.f, 0.f, 0.f, 0.f};
#pragma unroll
            for (int j = 0; j < 2; ++j) {
                const int st = sp * 2 + j;
                f32x4 acc = {0.f, 0.f, 0.f, 0.f};
#pragma unroll
                for (int ks = 0; ks < 2; ++ks) { const h16x8 kb = *(const LAS h16x8*)(KS + (st * 16 + fr) * 72 + ks * 32 + fq * 8); acc = mfma16(qa[ks], kb, acc); }
                const int s = st * 16 + fr; const float us = CUU[c * 64 + s];
#pragma unroll
                for (int r = 0; r < 4; ++r) {
                    const int t = tt * 16 + fq * 4 + r;
                    const float wgt = (s <= t) ? __expf(us - mx[r]) : 0.f;
                    const float pv = acc[r] * wgt; dpart[r] += pv; PP[t * 72 + s] = (h16)pv;
                }
            }
#pragma unroll
            for (int r = 0; r < 4; ++r) {
                float d = dpart[r]; d = row_sum16(d);
                if (fr == 0) DEN[sp * 64 + tt * 16 + fq * 4 + r] = d;
            }
            const int t = tid >> 3, part = tid & 7;
            const h16x8 q8 = *(const LAS h16x8*)(QS + t * 72 + part * 8);
            float a = 0.f;
#pragma unroll
            for (int j = 0; j < 8; ++j) a += (float)q8[j] * NL[part * 8 + j];
            a = dpp_add<0xB1>(a); a = dpp_add<0x4E>(a); a += __shfl_xor(a, 4);
            if (part == 0) DQN[t] = a;
        }
        lds_barrier();
        {
            const int tt = wave & 3, vp = wave >> 2, t = tt * 16 + fr;
            h16x8 pa[2], qa[2];
#pragma unroll
            for (int ks = 0; ks < 2; ++ks) { pa[ks] = *(const LAS h16x8*)(PP + t * 72 + ks * 32 + fq * 8); qa[ks] = *(const LAS h16x8*)(QS + t * 72 + ks * 32 + fq * 8); }
            const float mxt = fmaxf(mcur, CCM[c * 64 + t]);
            const float sc = __expf(mcur - mxt);
            const float den = DEN[t] + DEN[64 + t] + sc * DQN[t];
            const float inv = 1.f / fmaxf(fabsf(den), __expf(-(CBC[c * 64 + t] + mxt)));
            float hv[2][4], ssq = 0.f;
#pragma unroll
            for (int j = 0; j < 2; ++j) {
                const int vt = vp * 2 + j;
                f32x4 a1 = {0.f, 0.f, 0.f, 0.f}, a2 = {0.f, 0.f, 0.f, 0.f};
#pragma unroll
                for (int ks = 0; ks < 2; ++ks) {
                    const h16x8 vb = *(const LAS h16x8*)(VT + (vt * 16 + fr) * 72 + ks * 32 + fq * 8);
                    const h16x8 cbf = *(const LAS h16x8*)(CT + (vt * 16 + fr) * 72 + ks * 32 + fq * 8);
                    a1 = mfma16(vb, pa[ks], a1); a2 = mfma16(cbf, qa[ks], a2);
                }
                const h16x4 o4 = j == 0 ? oc0 : oc1;
#pragma unroll
                for (int r = 0; r < 4; ++r) { const float hh = (a1[r] + sc * a2[r]) * inv * sigm((float)o4[r]); hv[j][r] = hh; ssq += hh * hh; }
            }
            ssq += __shfl_xor(ssq, 16); ssq += __shfl_xor(ssq, 32);
            if (fq == 0) SSQ[vp * 64 + t] = ssq;
            lds_barrier();
            const float rstd = rsqrtf((SSQ[t] + SSQ[64 + t]) * (1.f / 64.f) + EPS);
            if (t < nv) {
#pragma unroll
                for (int j = 0; j < 2; ++j) {
                    const int v0 = h * 64 + (vp * 2 + j) * 16 + fq * 4;
                    const f32x4 nw = *(const f32x4*)(p.in[14] + v0);
                    f32x4 o;
#pragma unroll
                    for (int r = 0; r < 4; ++r) o[r] = hv[j][r] * rstd * nw[r];
                    *(h16x4*)(MIX + (size_t)(rowbase + t0 + t) * D + v0) = pack4(o);
                }
            }
        }
        {
#pragma unroll
            for (int j = 0; j < 2; ++j) {
                const int vt = (wave >> 2) * 2 + j;
                Cacc[j] *= dec;
#pragma unroll
                for (int ks = 0; ks < 2; ++ks) {
                    const h16x8 kwf = *(const LAS h16x8*)(KW + (kt * 16 + fr) * 72 + ks * 32 + fq * 8);
                    const h16x8 vf = *(const LAS h16x8*)(VT + (vt * 16 + fr) * 72 + ks * 32 + fq * 8);
                    Cacc[j] = mfma16(kwf, vf, Cacc[j]);
                }
                *(LAS h16x4*)(CT + (vt * 16 + fr) * 72 + kt * 16 + fq * 4) = pack4(Cacc[j]);
            }
            if (tid < 64) {
                float a = 0.f;
#pragma unroll
                for (int s8 = 0; s8 < 8; ++s8) { const h16x8 x = *(const LAS h16x8*)(KW + tid * 72 + s8 * 8);
#pragma unroll
                    for (int j = 0; j < 8; ++j) a += (float)x[j]; }
                NL[tid] = dec * NL[tid] + a;
            }
            mcur = mnew;
        }
        lds_barrier();
    }
#pragma unroll
    for (int j = 0; j < 2; ++j) {
        const int vt = (wave >> 2) * 2 + j;
#pragma unroll
        for (int r = 0; r < 4; ++r) ch.Cout[(size_t)(kt * 16 + fq * 4 + r) * 64 + vt * 16 + fr] = Cacc[j][r];
    }
    if (tid < 64) ch.nout[tid] = NL[tid];
    if (tid == 0) ch.mout[0] = mcur;
    if (tid < 384) {
        const int j = tid >> 7, cc = tid & 127, gcol = (cc < 64) ? h * 64 + cc : 512 + h * 64 + (cc - 64), tk = T - 3 + j;
        float v = 0.f;
        if (tk >= 0) v = (float)PROJ[(size_t)(rowbase + tk) * NPROJ + gcol];
        else if (ch.conv0) v = ch.conv0[(size_t)(3 + tk) * 1024 + gcol];
        ch.convout[(size_t)j * 1024 + gcol] = v;
    }
    __syncthreads();
}

__device__ __forceinline__ void mlstm_sample_task(const Params& p, int s, int h) {
    unsigned char* ws = p.ws;
    const int lane = threadIdx.x & 63, row = MP + s, i = s * 8 + h;
    const h16* pr = (const h16*)(ws + OFF_PROJ16) + (size_t)row * NPROJ;
    const float* C0 = p.in[2] + (size_t)i * 4096;
    float c0[64];
#pragma unroll
    for (int k = 0; k < 64; ++k) c0[k] = C0[k * 64 + lane];
    const int gq = h * 64 + lane, gk = 512 + h * 64 + lane;
    const float* cv = p.in[5] + (size_t)s * 3072;
    const float q0 = cv[gq], q1 = cv[1024 + gq], q2 = cv[2048 + gq], q3 = (float)pr[gq];
    const float k0 = cv[gk], k1 = cv[1024 + gk], k2 = cv[2048 + gk], k3 = (float)pr[gk];
    const float vv = (float)pr[1024 + h * 64 + lane], op = (float)pr[1536 + h * 64 + lane];
    const float* cwp = p.in[10];
    const float qc = p.in[11][gq] + q0 * cwp[gq] + q1 * cwp[1024 + gq] + q2 * cwp[2048 + gq] + q3 * cwp[3072 + gq];
    const float kc = p.in[11][gk] + k0 * cwp[gk] + k1 * cwp[1024 + gk] + k2 * cwp[2048 + gk] + k3 * cwp[3072 + gk];
    const float q = qc * sigm(qc), kk = kc * sigm(kc) * 0.125f;
    float* co = p.out + O_SCONV + (size_t)s * 3072;
    co[gq] = q1; co[1024 + gq] = q2; co[2048 + gq] = q3;
    co[gk] = k1; co[1024 + gk] = k2; co[2048 + gk] = k3;
    const float* gp = (const float*)(ws + OFF_GATES) + (size_t)row * 16;
    const float ig = gp[h], fg = gp[8 + h];
    const float lf = fminf(fg, 0.f) - __logf(1.f + __expf(-fabsf(fg)));
    const float m0 = p.in[4][i], n0 = p.in[3][(size_t)i * 64 + lane];
    const float inter = lf + m0, mt = fmaxf(inter, ig), wts = __expf(ig - mt), sc = __expf(inter - mt);
    const float qk = wave_sum(q * kk) * wts, qn = wave_sum(q * n0);
    const float den = qk + sc * qn, inv = 1.f / fmaxf(fabsf(den), __expf(-mt));
    float qc_acc = 0.f;
    float* Co = p.out + O_SC + (size_t)i * 4096;
    const int qb = __builtin_bit_cast(int, q), kb = __builtin_bit_cast(int, kk);
#pragma unroll
    for (int k = 0; k < 64; ++k) {
        const float qk_ = __builtin_bit_cast(float, __builtin_amdgcn_readlane(qb, k)), kk_ = __builtin_bit_cast(float, __builtin_amdgcn_readlane(kb, k));
        qc_acc += qk_ * c0[k];
        Co[k * 64 + lane] = sc * c0[k] + (wts * kk_) * vv;
    }
    const float hh = (qk * vv + sc * qc_acc) * inv * sigm(op);
    const float rstd = rsqrtf(wave_sum(hh * hh) * (1.f / 64.f) + EPS);
    ((h16*)((unsigned char*)p.out + OUTB_MIX16))[(size_t)row * D + gq] = (h16)(hh * rstd * p.in[14][gq]);
    p.out[O_SN + (size_t)i * 64 + lane] = sc * n0 + wts * kk;
    if (lane == 0) p.out[O_SM + i] = mt;
}
__device__ __forceinline__ void late_transposes(const Params& p, LAS unsigned char* lds, int w, int nw) {
    unsigned char* ws = p.ws;
    LAS float* tile = (LAS float*)lds;
    constexpr int I_OUT = 16 * 16, I_UP = 16 * 64, I_DN = 64 * 16;
    for (int it = w; it < I_OUT + I_UP + I_DN; it += nw) {
        int r = it;
        if (r < I_OUT) { tr_tile(p.in[26], 1024, 1024, r / 16, r % 16, tile, nullptr, (h16*)(ws + OFF_WT_OUT), 0, nullptr); continue; } r -= I_OUT;
        if (r < I_UP) { tr_tile(p.in[28], 1024, 4096, r / 64, r % 64, tile, p.in[27], (h16*)(ws + OFF_WT_UP), 0, nullptr); continue; } r -= I_UP;
        tr_tile(p.in[29], 4096, 1024, r / 16, r % 16, tile, nullptr, (h16*)(ws + OFF_WT_DN), 0, nullptr);
    }
}
__device__ __forceinline__ void p2_mixprep(const Params& p, LAS unsigned char* lds) {
    const int nb = gridDim.x, bid = blockIdx.x;
    if (bid < 64) {
        const int b = bid >> 3, h = bid & 7;
        MlChain ch; ch.rowbase = b * SEQ; ch.T = SEQ; ch.h = h; ch.C0 = nullptr; ch.n0 = nullptr; ch.m0 = nullptr; ch.conv0 = nullptr;
        ch.Cout = p.out + O_PC + (size_t)bid * 4096; ch.nout = p.out + O_PN + (size_t)bid * 64; ch.mout = p.out + O_PM + bid; ch.convout = p.out + O_PCONV + (size_t)b * 3072;
        mlstm_chain(p, lds, ch);
        return;
    }
    const int w = bid - 64, nw = nb - 64;
    for (int tile = w; tile < MALL / 32; tile += nw) rwkv_prep_tile(p, lds, tile);
    for (int i = w * 8 + (int)(threadIdx.x >> 6); i < MS * 8; i += nw * 8) mlstm_sample_task(p, i >> 3, i & 7);
    __syncthreads();
    late_transposes(p, lds, w, nw);
}

__device__ __forceinline__ void rwkv_scan_prompt(const Params& p, LAS unsigned char* lds, int bh, int rq) {
    constexpr int TC = 32, NCH = SEQ / TC, NPIECE = TC * 48 / 256;
    unsigned char* ws = p.ws;
    LAS float* OPS = (LAS float*)lds;
    LAS float* RKB = (LAS float*)(lds + 2 * TC * 6 * 64 * 4);
    const int tid = threadIdx.x, lane = tid & 63, wave = tid >> 6;
    const int b = bh >> 3, h = bh & 7, rowbase = b * SEQ;
    const h16* OPSG = (const h16*)(ws + OFF_OPS16);
    const float* RKS = (const float*)(ws + OFF_RKS);
    float* YRAW = (float*)(ws + OFF_YRAW);
    const int rr = lane >> 4, cg_ = lane & 15, rloc = (wave & 3) * 4 + rr;
    const int ltid = tid - 256;
    f32x4 S = {0.f, 0.f, 0.f, 0.f};
    h16x8 pre[NPIECE]; float prk = 0.f;
    auto issue_chunk = [&](int c) {
#pragma unroll
        for (int i = 0; i < NPIECE; ++i) {
            const int piece = ltid + 256 * i, tk = piece / 48, q = piece % 48, vec = q >> 3, c8 = q & 7;
            pre[i] = *(const h16x8*)(OPSG + (((size_t)(rowbase + c * TC + tk) * 8 + h) * 6 + vec) * 64 + c8 * 8);
        }
        if (ltid < TC) prk = RKS[(size_t)(rowbase + c * TC + ltid) * 8 + h];
    };
    auto store_chunk = [&](int buf) {
#pragma unroll
        for (int i = 0; i < NPIECE; ++i) {
            const int piece = ltid + 256 * i, tk = piece / 48, q = piece % 48, vec = q >> 3, c8 = q & 7;
            const h16x8 v = pre[i];
            f32x4 a, bb;
#pragma unroll
            for (int j = 0; j < 4; ++j) { a[j] = (float)v[j]; bb[j] = (float)v[4 + j]; }
            if (vec == 1) {
#pragma unroll
                for (int j = 0; j < 4; ++j) { a[j] = __expf(a[j]); bb[j] = __expf(bb[j]); }
            }
            LAS float* d = OPS + ((buf * TC + tk) * 6 + vec) * 64 + c8 * 8;
            *(LAS f32x4*)d = a; *(LAS f32x4*)(d + 4) = bb;
        }
        if (ltid < TC) RKB[buf * TC + ltid] = prk;
    };
    if (wave >= 4) { issue_chunk(0); store_chunk(0); issue_chunk(1); }
    lds_barrier();
    for (int c = 0; c < NCH; ++c) {
        const int buf = c & 1;
        if (wave >= 4) {
            if (c + 1 < NCH) store_chunk(buf ^ 1);
            if (c + 2 < NCH) issue_chunk(c + 2);
        } else {
            float yk[TC / 16];
#pragma unroll
            for (int j = 0; j < TC / 16; ++j) yk[j] = 0.f;
            const LAS float* ob = OPS + buf * TC * 6 * 64;
            f32x4 r4 = *(const LAS f32x4*)(ob + cg_ * 4), d4 = *(const LAS f32x4*)(ob + 64 + cg_ * 4), k4 = *(const LAS f32x4*)(ob + 128 + cg_ * 4),
                  a4 = *(const LAS f32x4*)(ob + 256 + cg_ * 4), b4 = *(const LAS f32x4*)(ob + 320 + cg_ * 4);
            float vv = ob[192 + rq * 16 + rloc];
            f32x4 rp = r4;
#pragma unroll
            for (int tk = 0; tk < TC; ++tk) {
                f32x4 nr4 = r4, nd4 = d4, nk4 = k4, na4 = a4, nb4 = b4; float nvv = vv;
                if (tk < TC - 1) {
                    const LAS float* o = ob + (tk + 1) * 6 * 64;
                    nr4 = *(const LAS f32x4*)(o + cg_ * 4); nd4 = *(const LAS f32x4*)(o + 64 + cg_ * 4); nk4 = *(const LAS f32x4*)(o + 128 + cg_ * 4);
                    na4 = *(const LAS f32x4*)(o + 256 + cg_ * 4); nb4 = *(const LAS f32x4*)(o + 320 + cg_ * 4);
                    nvv = o[192 + rq * 16 + rloc];
                }
                __builtin_amdgcn_sched_barrier(0);
                typedef float f32x2_ __attribute__((ext_vector_type(2)));
                f32x2_ ta = (f32x2_){S[0], S[1]} * (f32x2_){a4[0], a4[1]}; ta = (f32x2_){S[2], S[3]} * (f32x2_){a4[2], a4[3]} + ta;
                f32x2_ ty = (f32x2_){S[0], S[1]} * (f32x2_){rp[0], rp[1]}; ty = (f32x2_){S[2], S[3]} * (f32x2_){rp[2], rp[3]} + ty;
                const f32x4 T = S * d4 + vv * k4;
                float sa = ta[0] + ta[1];
                float yp = ty[0] + ty[1];
                sa = dpp_add<0xB1>(sa); yp = dpp_add<0xB1>(yp);
                sa = dpp_add<0x4E>(sa); yp = dpp_add<0x4E>(yp);
                sa = dpp_add<0x124>(sa); yp = dpp_add<0x124>(yp);
                sa = dpp_add<0x128>(sa); yp = dpp_add<0x128>(yp);
                if (tk > 0) yk[(tk - 1) >> 4] = (cg_ == ((tk - 1) & 15)) ? yp : yk[(tk - 1) >> 4];
                S = sa * b4 + T;
                rp = r4;
                r4 = nr4; d4 = nd4; k4 = nk4; a4 = na4; b4 = nb4; vv = nvv;
            }
            {
                float yp = S[0] * rp[0] + S[1] * rp[1] + S[2] * rp[2] + S[3] * rp[3];
                yp = row_sum16(yp);
                yk[(TC - 1) >> 4] = (cg_ == ((TC - 1) & 15)) ? yp : yk[(TC - 1) >> 4];
            }
#pragma unroll
            for (int j = 0; j < TC / 16; ++j) yk[j] += RKB[buf * TC + j * 16 + cg_] * ob[(j * 16 + cg_) * 6 * 64 + 192 + rq * 16 + rloc];
#pragma unroll
            for (int j = 0; j < TC / 16; ++j) YRAW[(size_t)(rowbase + c * TC + j * 16 + cg_) * 512 + h * 64 + rq * 16 + rloc] = yk[j];
        }
        lds_barrier();
    }
    if (wave < 4) *(f32x4*)(p.out + O_PS + ((size_t)bh * 64 + rq * 16 + rloc) * 64 + cg_ * 4) = S;
    __syncthreads();
}

__device__ __forceinline__ void rwkv_sample_task(const Params& p, int s, int h) {
    unsigned char* ws = p.ws;
    const int lane = threadIdx.x & 63, rr = lane >> 4, cg_ = lane & 15;
    const int row = MP + s;
    const h16* ob = (const h16*)(ws + OFF_OPS16) + ((size_t)row * 8 + h) * 6 * 64;
    f32x4 r4, d4, k4, a4, b4;
    {
        const h16x4 hr = *(const h16x4*)(ob + cg_ * 4), hw = *(const h16x4*)(ob + 64 + cg_ * 4), hk = *(const h16x4*)(ob + 128 + cg_ * 4),
                    ha = *(const h16x4*)(ob + 256 + cg_ * 4), hb = *(const h16x4*)(ob + 320 + cg_ * 4);
#pragma unroll
        for (int j = 0; j < 4; ++j) { r4[j] = (float)hr[j]; d4[j] = __expf((float)hw[j]); k4[j] = (float)hk[j]; a4[j] = (float)ha[j]; b4[j] = (float)hb[j]; }
    }
    const float rk = ((const float*)(ws + OFF_RKS))[(size_t)row * 8 + h];
    const float* S0 = p.in[6] + ((size_t)s * 8 + h) * 4096;
    float* So = p.out + O_SS + ((size_t)s * 8 + h) * 4096;
    float ysel = 0.f;
#pragma unroll
    for (int g = 0; g < 16; ++g) {
        const int vrow = g * 4 + rr;
        const float vv = (float)ob[192 + vrow];
        f32x4 S = *(const f32x4*)(S0 + (size_t)vrow * 64 + cg_ * 4);
        float sa = S[0] * a4[0] + S[1] * a4[1] + S[2] * a4[2] + S[3] * a4[3];
        sa = row_sum16(sa);
        S = S * d4 + sa * b4 + vv * k4;
        float y = S[0] * r4[0] + S[1] * r4[1] + S[2] * r4[2] + S[3] * r4[3];
        y = row_sum16(y) + rk * vv;
        *(f32x4*)(So + (size_t)vrow * 64 + cg_ * 4) = S;
        ysel = (cg_ == g) ? y : ysel;
    }
    const int vr = cg_ * 4 + rr, col = h * 64 + vr;
    const float mu = wave_sum(ysel) * (1.f / 64.f);
    const float dlt = ysel - mu;
    const float rstd = rsqrtf(wave_sum(dlt * dlt) * (1.f / 64.f) + GN_EPS);
    const float gte = (float)((const h16*)((unsigned char*)p.out + OUTB_G16))[(size_t)row * 512 + col];
    ((h16*)((unsigned char*)p.out + OUTB_MIX16))[(size_t)row * D + 512 + col] = (h16)((dlt * rstd * p.in[24][col] + p.in[25][col]) * gte);
}

__device__ __forceinline__ void p3_scan(const Params& p, LAS unsigned char* lds) {
    for (int j = blockIdx.x; j < 256; j += gridDim.x) {
        const int xcd = j & 7, slot = j >> 3;
        rwkv_scan_prompt(p, lds, xcd * 8 + (slot >> 2), slot & 3);
    }
    const int wave = threadIdx.x >> 6;
    for (int i = blockIdx.x * 8 + wave; i < MS * 8; i += gridDim.x * 8) rwkv_sample_task(p, i >> 3, i & 7);
}

__device__ __forceinline__ void groupnorm_rows(const Params& p, int rbeg, int rend) {
    unsigned char* ws = p.ws;
    const int lane = threadIdx.x & 63, wave = threadIdx.x >> 6, c = lane * 8;
    const float* YRAW = (const float*)(ws + OFF_YRAW);
    const h16* G16 = (const h16*)((unsigned char*)p.out + OUTB_G16);
    h16* MIX = (h16*)((unsigned char*)p.out + OUTB_MIX16);
    const f32x4 w0 = *(const f32x4*)(p.in[24] + c), w1 = *(const f32x4*)(p.in[24] + c + 4), b0 = *(const f32x4*)(p.in[25] + c), b1 = *(const f32x4*)(p.in[25] + c + 4);
    const int stride = 8;
    for (int row0 = rbeg + wave; row0 < rend; row0 += 4 * stride) {
        f32x4 ya[4], yb[4]; h16x8 gg[4];
#pragma unroll
        for (int u = 0; u < 4; ++u) {
            const int r = row0 + u * stride, rc = r < rend ? r : row0;
            ya[u] = *(const f32x4*)(YRAW + (size_t)rc * 512 + c); yb[u] = *(const f32x4*)(YRAW + (size_t)rc * 512 + c + 4);
            gg[u] = *(const h16x8*)(G16 + (size_t)rc * 512 + c);
        }
#pragma unroll
        for (int u = 0; u < 4; ++u) {
            const int row = row0 + u * stride;
            f32x4 y0 = ya[u], y1 = yb[u];
            float s = y0[0] + y0[1] + y0[2] + y0[3] + y1[0] + y1[1] + y1[2] + y1[3];
            s = dpp_add<0xB1>(s); s = dpp_add<0x4E>(s); s += __shfl_xor(s, 4);
            const float mu = s * (1.f / 64.f);
            y0 -= mu; y1 -= mu;
            float q = y0[0] * y0[0] + y0[1] * y0[1] + y0[2] * y0[2] + y0[3] * y0[3] + y1[0] * y1[0] + y1[1] * y1[1] + y1[2] * y1[2] + y1[3] * y1[3];
            q = dpp_add<0xB1>(q); q = dpp_add<0x4E>(q); q += __shfl_xor(q, 4);
            const float rstd = rsqrtf(q * (1.f / 64.f) + GN_EPS);
            f32x4 o0, o1;
#pragma unroll
            for (int j = 0; j < 4; ++j) { o0[j] = (y0[j] * rstd * w0[j] + b0[j]) * (float)gg[u][j]; o1[j] = (y1[j] * rstd * w1[j] + b1[j]) * (float)gg[u][4 + j]; }
            if (row < rend) *(h16x8*)(MIX + (size_t)row * D + 512 + c) = pack8(o0, o1);
        }
    }
}

__device__ __forceinline__ void p7_final(const Params& p, bool prompt_done) {
    unsigned char* ws = p.ws;
    const int lane = threadIdx.x & 63, wave = threadIdx.x >> 6;
    const float* nw = p.in[30];
    const float* SS2 = (const float*)(ws + OFF_SS2);
    const h16* X2 = (const h16*)(ws + OFF_X1);
    f32x4 w[4];
#pragma unroll
    for (int j = 0; j < 4; ++j) w[j] = *(const f32x4*)(nw + lane * 4 + 256 * j);
    const int stride = gridDim.x * 8;
    if (!prompt_done)
    for (int row = blockIdx.x * 8 + wave; row < MP; row += 4 * stride) {
        h16x4 v[4][4]; float rstd[4];
#pragma unroll
        for (int u = 0; u < 4; ++u) {
            const int r = row + u * stride, rc = r < MP ? r : row;
            rstd[u] = rsqrtf(SS2[rc] * (1.f / D) + EPS);
#pragma unroll
            for (int j = 0; j < 4; ++j) v[u][j] = *(const h16x4*)(X2 + (size_t)rc * D + lane * 4 + 256 * j);
        }
#pragma unroll
        for (int u = 0; u < 4; ++u) {
            const int r = row + u * stride;
            if (r < MP) {
#pragma unroll
                for (int j = 0; j < 4; ++j) {
                    f32x4 o;
#pragma unroll
                    for (int e = 0; e < 4; ++e) o[e] = (float)v[u][j][e] * rstd[u] * w[j][e];
                    *(f32x4*)(p.out + O_YP + (size_t)r * D + lane * 4 + 256 * j) = o;
                }
            }
        }
    }
    for (int s = blockIdx.x * 8 + wave; s < MS; s += stride) {
        float* xr = p.out + O_YS + (size_t)s * D;
        const float rstd = rsqrtf(SS2[MP + s] * (1.f / D) + EPS);
#pragma unroll
        for (int j = 0; j < 4; ++j) { const f32x4 v = *(const f32x4*)(xr + lane * 4 + 256 * j); *(f32x4*)(xr + lane * 4 + 256 * j) = v * rstd * w[j]; }
    }
}

__global__ void __launch_bounds__(512, 2) hymba_fwd(Params p) {
    extern __shared__ __attribute__((aligned(16))) unsigned char shm[];
    LAS unsigned char* lds = (LAS unsigned char*)shm;
    cg::grid_group grid = cg::this_grid();
    unsigned char* ws = p.ws;
    const int G = gridDim.x, c = blockIdx.x;

    XB xb; xb.bar = (unsigned*)(ws + OFF_BAR); xb.x = xb_xcc_id();
    if (c == 0) for (int i = threadIdx.x; i < 2176; i += 512) xb.bar[1024 + i] = 0u;
    if (threadIdx.x == 0) xb.bar[3200 + c] = xb.x;
    p0_prep(p, lds);
    grid.sync();
    {
        LAS unsigned* hist = (LAS unsigned*)lds;
        if (threadIdx.x < 16) hist[threadIdx.x] = 0u;
        __syncthreads();
        for (int i = threadIdx.x; i < G; i += 512) atomicAdd((unsigned*)(hist + (xb_ld(&xb.bar[3200 + i]) & 15u)), 1u);
        __syncthreads();
        unsigned cnt = 0u;
#pragma unroll
        for (unsigned j = 0; j < 16; ++j) cnt += (hist[j] > 0u) ? 1u : 0u;
        const unsigned mine = hist[xb.x];
        xb.nloc = mine > 0u ? mine : 1u; xb.nx = cnt > 0u ? cnt : 1u;
        __syncthreads();
    }
    {
        pg8::Gemm g{(const h16*)(ws + OFF_XN16), (const h16*)(ws + OFF_WT_IN), MPAD, NPROJ, D};
        pg8::StaticOrder S; S.init(MPAD, NPROJ, G, c);
        Epi<0> E{(h16*)(ws + OFF_PROJ16), NPROJ, nullptr, 0, nullptr, 0, nullptr, nullptr};
        pg8::gemm_phase(lds, g, S, E);
        skinny<SK_GATES>(p, (const h16*)(ws + OFF_XN16), D, 0, MALL / 16, (const h16*)(ws + OFF_WT_G), D, 1);
    }
    xcd_barrier(xb);
    p2_mixprep(p, lds);
    xcd_barrier(xb);
    p3_scan(p, lds);
    xcd_barrier(xb);
    {
        const h16* MIX = (const h16*)((unsigned char*)p.out + OUTB_MIX16);
        pg8::Gemm g{MIX, (const h16*)(ws + OFF_WT_OUT), MP, D, D};
        pg8::StaticOrder S; S.init(MP, D, G, c);
        { pg8::Unit u0; for (int i = 0; S.next(i, u0); ++i) groupnorm_rows(p, u0.pm * 256, u0.pm * 256 + 256); }
        asm volatile("s_waitcnt vmcnt(0)" ::: "memory");
        __syncthreads();
        Epi<1> E{(h16*)(ws + OFF_X116), D, nullptr, 0, p.in[0], D, (float*)(ws + OFF_SS1), nullptr};
        pg8::gemm_phase(lds, g, S, E);
        skinny<SK_OUT>(p, MIX, D, MP, MS / 16, (const h16*)(ws + OFF_WT_OUT), D, D / 16);
    }
    xcd_barrier(xb);
    {
        pg8::Gemm g{(const h16*)(ws + OFF_X116), (const h16*)(ws + OFF_WT_UP), MP, DFF, D};
        pg8::StaticOrder S; S.init(MP, DFF, G, c);
        Epi<2> E{(h16*)(ws + OFF_HID16), DFF, nullptr, 0, nullptr, 0, (float*)(ws + OFF_SS1), nullptr};
        pg8::gemm_phase(lds, g, S, E);
        skinny<SK_UP>(p, (const h16*)(ws + OFF_X116), D, MP, MS / 16, (const h16*)(ws + OFF_WT_UP), D, DFF / 16);
    }
    xcd_barrier(xb);
    {
        pg8::Gemm g{(const h16*)(ws + OFF_HID16), (const h16*)(ws + OFF_WT_DN), MP, D, DFF};
        pg8::StaticOrder S; S.init(MP, D, G, c);
        if (G == 256) {
            EpiFinal E{p.out + O_YP, (const h16*)(ws + OFF_X116), (float*)(ws + OFF_SS2), (unsigned*)(ws + OFF_CNT), p.in[30]};
            pg8::gemm_phase(lds, g, S, E);
        } else {
            Epi<3> E{(h16*)(ws + OFF_X1), D, nullptr, 0, nullptr, D, (float*)(ws + OFF_SS2), (const h16*)(ws + OFF_X116)};
            pg8::gemm_phase(lds, g, S, E);
        }
        skinny_down_splitk(p, lds);
    }
    xcd_barrier(xb);
    p7_final(p, G == 256);
}

extern "C" void kernel_launch(void* const* d_in, const int* in_sizes, int n_in, void* d_out, int out_size, void* d_ws, size_t ws_size, hipStream_t stream) {
    static int grid_blocks = 0;
    if (grid_blocks == 0) {
        int dev = 0, cus = 0, per_cu = 0;
        (void)hipGetDevice(&dev);
        (void)hipDeviceGetAttribute(&cus, hipDeviceAttributeMultiprocessorCount, dev);
        if (hipFuncSetAttribute((const void*)hymba_fwd, hipFuncAttributeMaxDynamicSharedMemorySize, LDS_BYTES) != hipSuccess) fprintf(stderr, "hipFuncSetAttribute failed\n");
        if (hipOccupancyMaxActiveBlocksPerMultiprocessor(&per_cu, (const void*)hymba_fwd, 512, LDS_BYTES) != hipSuccess || per_cu < 1) { fprintf(stderr, "occupancy query: %d\n", per_cu); per_cu = 1; }
        (void)hipGetLastError();
        grid_blocks = cus;
        if (ws_size < 268435456ull) fprintf(stderr, "workspace too small: %zu\n", ws_size);
    }
    Params p{};
    for (int i = 0; i < 31; ++i) p.in[i] = (const float*)d_in[i];
    p.out = (float*)d_out; p.ws = (unsigned char*)d_ws;
    void* args[] = {&p};
    hipError_t e = hipLaunchCooperativeKernel((const void*)hymba_fwd, dim3(grid_blocks), dim3(512), args, LDS_BYTES, stream);
    if (e != hipSuccess) fprintf(stderr, "cooperative launch failed: %s (grid %d)\n", hipGetErrorString(e), grid_blocks);
}
```

```cpp
#include <hip/hip_runtime.h>
#include <hip/hip_cooperative_groups.h>
#include <cstdio>
namespace cg = cooperative_groups;

#define LAS __attribute__((address_space(3)))
typedef _Float16 h16;
typedef _Float16 h16x8 __attribute__((ext_vector_type(8)));
typedef _Float16 h16x4 __attribute__((ext_vector_type(4)));
typedef float f32x4 __attribute__((ext_vector_type(4)));
typedef unsigned u32x4 __attribute__((ext_vector_type(4)));

constexpr int D = 1024, MP = 16384, MS = 128, MALL = 16512, MPAD = 16640, SEQ = 2048;
constexpr int NPROJ = 3840;
constexpr int RWW = 1792, DFF = 4096;
constexpr float EPS = 1e-6f, GN_EPS = 64e-5f;
constexpr int LDS_BYTES = 131072;

constexpr size_t OFF_WT_IN = 0;
constexpr size_t OFF_WT_G = OFF_WT_IN + (size_t)NPROJ * D * 2;
constexpr size_t OFF_WT_OUT = OFF_WT_G + 16 * D * 2;
constexpr size_t OFF_WT_UP = OFF_WT_OUT + (size_t)D * D * 2;
constexpr size_t OFF_WT_DN = OFF_WT_UP + (size_t)DFF * D * 2;
constexpr size_t OFF_LW = OFF_WT_DN + (size_t)DFF * D * 2;
constexpr size_t OFF_LA = OFF_LW + 512 * 64 * 2;
constexpr size_t OFF_LG = OFF_LA + 512 * 64 * 2;
constexpr size_t OFF_GATES = OFF_LG + 512 * 128 * 2;
constexpr size_t OFF_SS1 = OFF_GATES + (size_t)MPAD * 16 * 4;
constexpr size_t OFF_SS2 = OFF_SS1 + (size_t)MPAD * 4;
constexpr size_t OFF_RKS = OFF_SS2 + (size_t)MPAD * 4;
constexpr size_t OFF_CNT = OFF_RKS + (size_t)MPAD * 8 * 4;
constexpr size_t OFF_BAR = OFF_CNT + 256;
constexpr size_t OFF_DYN = OFF_BAR + 16384;
constexpr size_t OFF_XN16 = OFF_DYN;
constexpr size_t OFF_OPS16 = OFF_DYN;
constexpr size_t OFF_PROJ16 = 268435456ull - (size_t)MPAD * NPROJ * 2;
constexpr size_t OFF_YRAW = OFF_PROJ16;
constexpr size_t OFF_X1 = OFF_DYN;
constexpr size_t OFF_X116 = OFF_X1 + (size_t)MPAD * D * 4;
constexpr size_t OFF_HID16 = OFF_X116 + (size_t)MPAD * D * 2;
static_assert(OFF_DYN % 256 == 0 && OFF_PROJ16 % 256 == 0, "align");
static_assert(OFF_OPS16 + (size_t)MALL * 8 * 6 * 64 * 2 <= OFF_PROJ16, "ops overlap");
static_assert(OFF_HID16 + (size_t)MPAD * DFF * 2 <= 268435456ull, "ws overflow");
constexpr size_t OUTB_MIX16 = 0, OUTB_G16 = (size_t)MPAD * D * 2;
static_assert(OUTB_G16 + (size_t)MALL * 512 * 2 <= (size_t)MP * D * 4, "out scratch overflow");
constexpr size_t O_YP = 0, O_YS = 16777216, O_PC = 16908288, O_PN = 17170432, O_PM = 17174528, O_PCONV = 17174592, O_PS = 17199168,
                 O_PSH = 17461312, O_SC = 17475648, O_SN = 21669952, O_SM = 21735488, O_SCONV = 21736512, O_SS = 22129728, O_SSH = 26324032;

struct Params { const float* in[31]; float* out; unsigned char* ws; };

__device__ __forceinline__ f32x4 mfma16(h16x8 a, h16x8 b, f32x4 c) { return __builtin_amdgcn_mfma_f32_16x16x32_f16(a, b, c, 0, 0, 0); }
__device__ __forceinline__ float wave_sum(float v) {
#pragma unroll
    for (int o = 1; o < 64; o <<= 1) v += __shfl_xor(v, o);
    return v;
}
__device__ __forceinline__ float wave_max(float v) {
#pragma unroll
    for (int o = 1; o < 64; o <<= 1) v = fmaxf(v, __shfl_xor(v, o));
    return v;
}
__device__ __forceinline__ void lds_barrier() { asm volatile("s_waitcnt lgkmcnt(0)\n\ts_barrier" ::: "memory"); }
#define XB_XCNT(j) (64 * (j))
#define XB_XSUB(j) (1024 + 64 * (j))
#define XB_XGEN(j) (2048 + 64 * (j))
#define XB_TOP 3072
#define XB_TOPGEN 3136
__device__ __forceinline__ unsigned xb_ld(unsigned* p) { return __hip_atomic_load(p, __ATOMIC_RELAXED, __HIP_MEMORY_SCOPE_AGENT); }
__device__ __forceinline__ unsigned xb_add(unsigned* p, unsigned v) { return __hip_atomic_fetch_add(p, v, __ATOMIC_RELAXED, __HIP_MEMORY_SCOPE_AGENT); }
__device__ __forceinline__ unsigned xb_xcc_id() { return (unsigned)__builtin_amdgcn_s_getreg((3 << 11) | 20) & 0xFu; }
struct XB { unsigned* bar; unsigned x, nloc, nx; };
__device__ __forceinline__ void xcd_barrier(const XB& b) {
    __syncthreads();
    if (threadIdx.x == 0) {
        unsigned* bar = b.bar;
        __builtin_amdgcn_fence(__ATOMIC_RELEASE, "agent");
        asm volatile("s_waitcnt vmcnt(0)" ::: "memory");
        const unsigned old = xb_add(&bar[XB_XSUB(b.x)], 1u);
        const unsigned gen = old / b.nloc;
        if (old + 1u == (gen + 1u) * b.nloc) {
            const unsigned og = xb_add(&bar[XB_TOP], 1u);
            const unsigned target = (og / b.nx + 1u) * b.nx;
            if (og + 1u != target) while (xb_ld(&bar[XB_TOP]) < target) __builtin_amdgcn_s_sleep(1);
            xb_add(&bar[XB_XGEN(b.x)], 1u);
        } else {
            while (xb_ld(&bar[XB_XGEN(b.x)]) == gen) __builtin_amdgcn_s_sleep(1);
        }
        __builtin_amdgcn_fence(__ATOMIC_ACQUIRE, "agent");
        asm volatile("s_waitcnt vmcnt(0)" ::: "memory");
    }
    __syncthreads();
}
__device__ __forceinline__ float sigm(float x) { return __builtin_amdgcn_rcpf(1.f + __expf(-x)); }
template <int CTRL> __device__ __forceinline__ float dpp_add(float x) {
    return x + __builtin_bit_cast(float, __builtin_amdgcn_update_dpp(0, __builtin_bit_cast(int, x), CTRL, 0xF, 0xF, true));
}
__device__ __forceinline__ float row_sum16(float x) { x = dpp_add<0xB1>(x); x = dpp_add<0x4E>(x); x = dpp_add<0x124>(x); x = dpp_add<0x128>(x); return x; }

namespace pg8 {
constexpr int BM = 256, BK = 64, HALF = 128, HTB = HALF * BK * 2, NXCD = 8, WGM = 8;
__device__ __forceinline__ int lds_byte(int r, int c) { const int st = (r >> 4) * 2 + (c >> 5), rr = r & 15, cc = c & 31, ob = rr * 64 + cc * 2; return st * 1024 + (ob ^ (((ob >> 9) & 1) << 5)); }
__device__ __forceinline__ void stage_rc(int b, int& R, int& C) { const int st = b / 1024, sb = b % 1024, swz = sb ^ (((sb >> 9) & 1) << 5); R = (st >> 1) * 16 + swz / 64; C = (st & 1) * 32 + (swz % 64) / 2; }
__device__ __forceinline__ int perm32(int rho) { const int n = rho >> 4, i = rho & 15; return 8 * (i >> 2) + 4 * n + (i & 3); }
struct Unit { int pm, pn; };
struct Gemm { const h16* A; const h16* Bt; int M, N, K; };
struct StaticOrder {
    int nM, nN, nwg, G, c;
    __device__ void init(int M, int N, int G_, int c_) { nM = M / BM; nN = N / BM; nwg = nM * nN; G = G_; c = c_; }
    __device__ bool next(int i, Unit& u) const {
        const long L = (long)i * G + c; if (L >= nwg) return false;
        int wgid = (int)L; { const int q = nwg / NXCD, r = nwg % NXCD, xcd = wgid % NXCD, off = wgid / NXCD; wgid = (xcd < r ? xcd * (q + 1) : r * (q + 1) + (xcd - r) * q) + off; }
        const int nig = WGM * nN, gid = wgid / nig, fm = gid * WGM, gsz = (nM - fm) < WGM ? (nM - fm) : WGM;
        u.pm = fm + ((wgid % nig) % gsz); u.pn = (wgid % nig) / gsz; return true;
    }
};

template <class Epi>
__device__ __forceinline__ void gemm_phase(LAS unsigned char* lds, const Gemm g, const StaticOrder& S, const Epi& E) {
    int tid = threadIdx.x;
    asm volatile("" : "+v"(tid));
    const int wid = __builtin_amdgcn_readfirstlane(tid >> 6), lane = tid & 63, wr = wid >> 2, wc = wid & 3, fr = lane & 15, fq = lane >> 4;
    const int K = g.K, nt = K / BK;
    unsigned voffA[2], voffB[2];
#pragma unroll
    for (int i = 0; i < 2; ++i) { int R, C; stage_rc(tid * 16 + i * 8192, R, C); const int Rb = (R & ~31) + perm32(R & 31);
        voffA[i] = (unsigned)(R * K + C) * 2u; voffB[i] = (unsigned)(Rb * K + C) * 2u; }
    const size_t kstep = (size_t)(BK * 2);
    const size_t hstep = (size_t)HALF * K * 2;
    const size_t tstep = 2 * hstep;
    const unsigned ldsw = (unsigned)wid * 1024u;
    const int aoff = lds_byte(wr * 64 + fr, fq * 8), boff = lds_byte(wc * 32 + fr, fq * 8);
#define PG8_SA(b, h) (((b) * 2 + (h)) * HTB)
#define PG8_SB(b, h) ((4 + (b) * 2 + (h)) * HTB)
#define PG8_STAGE(bufoff, gbase, voff) do { _Pragma("unroll") for (int _i = 0; _i < 2; ++_i) \
        __builtin_amdgcn_global_load_lds((const unsigned*)((const char*)(gbase) + (voff)[_i]), (LAS unsigned*)(lds + (bufoff) + ldsw + _i * 8192), 16, 0, 0); } while (0)
#define PG8_LDA(dst, b, h) do { _Pragma("unroll") for (int m = 0; m < 4; ++m) _Pragma("unroll") for (int k = 0; k < 2; ++k) dst[m][k] = *(const LAS h16x8*)(lds + PG8_SA(b, h) + aoff + m * 2048 + k * 1024); } while (0)
#define PG8_LDB(dst, b, h) do { _Pragma("unroll") for (int n = 0; n < 2; ++n) _Pragma("unroll") for (int k = 0; k < 2; ++k) dst[n][k] = *(const LAS h16x8*)(lds + PG8_SB(b, h) + boff + n * 2048 + k * 1024); } while (0)
#define PG8_MMA(ai, bj, At, Bt) do { __builtin_amdgcn_s_setprio(1); _Pragma("unroll") for (int m = 0; m < 4; ++m) _Pragma("unroll") for (int n = 0; n < 2; ++n) _Pragma("unroll") for (int k = 0; k < 2; ++k) \
        acc[ai][bj][m][n] = __builtin_amdgcn_mfma_f32_16x16x32_f16(Bt[n][k], At[m][k], acc[ai][bj][m][n], 0, 0, 0); __builtin_amdgcn_s_setprio(0); } while (0)
#define PG8_WAIT_V(n) asm volatile("s_waitcnt vmcnt(" #n ")" ::: "memory")
#define PG8_WAIT_L(n) asm volatile("s_waitcnt lgkmcnt(" #n ")" ::: "memory")
#define PG8_BAR __builtin_amdgcn_s_barrier()
#define PG8_SCHED __builtin_amdgcn_sched_barrier(0)
    Unit cur, nxt; int ui = 0;
    if (!S.next(0, cur)) return;
    f32x4 acc[2][2][4][2];
#pragma unroll
    for (int a = 0; a < 2; ++a)
#pragma unroll
        for (int b = 0; b < 2; ++b)
#pragma unroll
            for (int m = 0; m < 4; ++m)
#pragma unroll
                for (int n = 0; n < 2; ++n) acc[a][b][m][n] = (f32x4){0.f, 0.f, 0.f, 0.f};
    h16x8 At[4][2], B0[2][2], B1[2][2];
    const char* cA = (const char*)g.A + (size_t)cur.pm * tstep; const char* cB = (const char*)g.Bt + (size_t)cur.pn * tstep;
    PG8_STAGE(PG8_SB(0, 0), cB, voffB); PG8_STAGE(PG8_SA(0, 0), cA, voffA); PG8_STAGE(PG8_SB(0, 1), cB + hstep, voffB); PG8_STAGE(PG8_SA(0, 1), cA + hstep, voffA);
    if (wr == 1) PG8_BAR;
    PG8_WAIT_V(4); PG8_BAR;
    PG8_STAGE(PG8_SB(1, 0), cB + kstep, voffB); PG8_STAGE(PG8_SA(1, 0), cA + kstep, voffA); PG8_STAGE(PG8_SB(1, 1), cB + hstep + kstep, voffB);
    PG8_WAIT_V(6); PG8_BAR;
    for (;;) {
        const bool has_next = S.next(ui + 1, nxt);
        const char* nA = has_next ? (const char*)g.A + (size_t)nxt.pm * tstep : cA; const char* nB = has_next ? (const char*)g.Bt + (size_t)nxt.pn * tstep : cB;
        for (int t = 0; t < nt; t += 2) {
            const bool last = (t == nt - 2);
            const char* a1 = cA + (size_t)(t + 1) * kstep;
            const char* a2 = last ? nA : cA + (size_t)(t + 2) * kstep; const char* b2 = last ? nB : cB + (size_t)(t + 2) * kstep;
            const char* a3 = a2 + kstep; const char* b3 = b2 + kstep;
            PG8_LDB(B0, 0, 0); PG8_SCHED; PG8_LDA(At, 0, 0); PG8_STAGE(PG8_SA(1, 1), a1 + hstep, voffA);
            PG8_WAIT_L(8); PG8_BAR; PG8_WAIT_L(0); PG8_MMA(0, 0, At, B0); PG8_BAR; PG8_SCHED;
            PG8_LDB(B1, 0, 1); PG8_STAGE(PG8_SB(0, 0), b2, voffB);
            PG8_BAR; PG8_WAIT_L(0); PG8_MMA(0, 1, At, B1); PG8_BAR;
            PG8_LDA(At, 0, 1); PG8_STAGE(PG8_SA(0, 0), a2, voffA);
            PG8_BAR; PG8_WAIT_L(0); PG8_MMA(1, 0, At, B0); PG8_BAR; PG8_SCHED;
            PG8_STAGE(PG8_SB(0, 1), b2 + hstep, voffB);
            PG8_WAIT_V(6); PG8_BAR; PG8_MMA(1, 1, At, B1); PG8_BAR;
            PG8_LDB(B0, 1, 0); PG8_SCHED; PG8_LDA(At, 1, 0); PG8_STAGE(PG8_SA(0, 1), a2 + hstep, voffA);
            PG8_WAIT_L(8); PG8_BAR; PG8_WAIT_L(0); PG8_MMA(0, 0, At, B0); PG8_BAR; PG8_SCHED;
            PG8_LDB(B1, 1, 1); PG8_STAGE(PG8_SB(1, 0), b3, voffB);
            PG8_BAR; PG8_WAIT_L(0); PG8_MMA(0, 1, At, B1); PG8_BAR;
            PG8_LDA(At, 1, 1); PG8_STAGE(PG8_SA(1, 0), a3, voffA);
            PG8_BAR; PG8_WAIT_L(0); PG8_MMA(1, 0, At, B0); PG8_BAR; PG8_SCHED;
            PG8_STAGE(PG8_SB(1, 1), b3 + hstep, voffB);
            PG8_WAIT_V(6); PG8_BAR; PG8_MMA(1, 1, At, B1); PG8_BAR;
        }
        if constexpr (!Epi::AFTER_DRAIN) E(acc, cur, wr, wc, fr, fq);
        if (!has_next) break;
#pragma unroll
        for (int a = 0; a < 2; ++a)
#pragma unroll
            for (int b = 0; b < 2; ++b)
#pragma unroll
                for (int m = 0; m < 4; ++m)
#pragma unroll
                    for (int n = 0; n < 2; ++n) acc[a][b][m][n] = (f32x4){0.f, 0.f, 0.f, 0.f};
        cur = nxt; cA = nA; cB = nB; ++ui;
    }
    PG8_WAIT_V(0);
    if (wr == 0) PG8_BAR;
    PG8_BAR;
    if constexpr (Epi::AFTER_DRAIN) E(acc, cur, wr, wc, fr, fq);
#undef PG8_SA
#undef PG8_SB
#undef PG8_STAGE
#undef PG8_LDA
#undef PG8_LDB
#undef PG8_MMA
#undef PG8_WAIT_V
#undef PG8_WAIT_L
#undef PG8_BAR
#undef PG8_SCHED
}
}

__device__ __forceinline__ h16x8 pack8(f32x4 a, f32x4 b) {
    h16x8 o; o[0] = (h16)a[0]; o[1] = (h16)a[1]; o[2] = (h16)a[2]; o[3] = (h16)a[3]; o[4] = (h16)b[0]; o[5] = (h16)b[1]; o[6] = (h16)b[2]; o[7] = (h16)b[3]; return o;
}
__device__ __forceinline__ h16x4 pack4(f32x4 a) { h16x4 o; o[0] = (h16)a[0]; o[1] = (h16)a[1]; o[2] = (h16)a[2]; o[3] = (h16)a[3]; return o; }

template <int MODE> struct Epi {
    static constexpr bool AFTER_DRAIN = false;
    h16* o16; int ld16; float* o32; int ld32; const float* res; int ldres; float* rowss; const h16* res16;
    __device__ __forceinline__ void operator()(const f32x4 (&acc)[2][2][4][2], const pg8::Unit& u, int wr, int wc, int fr, int fq) const {
        const int row0 = u.pm * 256 + wr * 64 + fr, col0 = u.pn * 256 + wc * 32 + 8 * fq;
#pragma unroll
        for (int ai = 0; ai < 2; ++ai)
#pragma unroll
            for (int m = 0; m < 4; ++m) {
                const int row = row0 + ai * 128 + m * 16;
                float ss = 0.f, rstd = 1.f;
                if (MODE == 2) rstd = rsqrtf(rowss[row] * (1.f / 1024.f) + EPS);
#pragma unroll
                for (int bj = 0; bj < 2; ++bj) {
                    const int c = col0 + bj * 128;
                    f32x4 v0 = acc[ai][bj][m][0], v1 = acc[ai][bj][m][1];
                    if (MODE == 1) {
                        const float* rp = res + (size_t)row * ldres + c;
                        v0 += *(const f32x4*)rp; v1 += *(const f32x4*)(rp + 4);
                    }
                    if (MODE == 3) {
                        const h16x8 r8 = *(const h16x8*)(res16 + (size_t)row * ldres + c);
#pragma unroll
                        for (int j = 0; j < 4; ++j) { v0[j] += (float)r8[j]; v1[j] += (float)r8[4 + j]; }
                    }
                    if (MODE == 1 || MODE == 3) {
                        ss += v0[0] * v0[0] + v0[1] * v0[1] + v0[2] * v0[2] + v0[3] * v0[3] + v1[0] * v1[0] + v1[1] * v1[1] + v1[2] * v1[2] + v1[3] * v1[3];
                    }
                    if (MODE == 2) {
#pragma unroll
                        for (int j = 0; j < 4; ++j) { float a = fmaxf(v0[j] * rstd, 0.f), b = fmaxf(v1[j] * rstd, 0.f); v0[j] = a * a; v1[j] = b * b; }
                    }
                    *(h16x8*)(o16 + (size_t)row * ld16 + c) = pack8(v0, v1);
                }
                if (MODE == 1 || MODE == 3) {
                    ss += __shfl_xor(ss, 16); ss += __shfl_xor(ss, 32);
                    if (fq == 0) atomicAdd(rowss + row, ss);
                }
            }
    }
};

struct EpiFinal {
    static constexpr bool AFTER_DRAIN = true;
    float* out; const h16* res16; float* rowss; unsigned* cnt; const float* nw;
    __device__ __forceinline__ void operator()(f32x4 (&acc)[2][2][4][2], const pg8::Unit& u, int wr, int wc, int fr, int fq) const {
        const int row0 = u.pm * 256 + wr * 64 + fr, col0 = u.pn * 256 + wc * 32 + 8 * fq;
#pragma unroll
        for (int ai = 0; ai < 2; ++ai)
#pragma unroll
            for (int m = 0; m < 4; ++m) {
                const int row = row0 + ai * 128 + m * 16;
                float ss = 0.f;
#pragma unroll
                for (int bj = 0; bj < 2; ++bj) {
                    const int c = col0 + bj * 128;
                    const h16x8 r8 = *(const h16x8*)(res16 + (size_t)row * D + c);
                    f32x4 v0 = acc[ai][bj][m][0], v1 = acc[ai][bj][m][1];
#pragma unroll
                    for (int j = 0; j < 4; ++j) { v0[j] += (float)r8[j]; v1[j] += (float)r8[4 + j]; }
                    acc[ai][bj][m][0] = v0; acc[ai][bj][m][1] = v1;
                    ss += v0[0] * v0[0] + v0[1] * v0[1] + v0[2] * v0[2] + v0[3] * v0[3] + v1[0] * v1[0] + v1[1] * v1[1] + v1[2] * v1[2] + v1[3] * v1[3];
                }
                ss += __shfl_xor(ss, 16); ss += __shfl_xor(ss, 32);
                if (fq == 0) atomicAdd(rowss + row, ss);
            }
        asm volatile("s_waitcnt vmcnt(0)" ::: "memory");
        __syncthreads();
        if (threadIdx.x == 0) {
            __hip_atomic_fetch_add(cnt + u.pm, 1u, __ATOMIC_RELAXED, __HIP_MEMORY_SCOPE_AGENT);
            unsigned spins = 0;
            while (__hip_atomic_load(cnt + u.pm, __ATOMIC_RELAXED, __HIP_MEMORY_SCOPE_AGENT) < 4u && ++spins < (1u << 20)) __builtin_amdgcn_s_sleep(1);
        }
        __syncthreads();
#pragma unroll
        for (int ai = 0; ai < 2; ++ai)
#pragma unroll
            for (int m = 0; m < 4; ++m) {
                const int row = row0 + ai * 128 + m * 16;
                const float rstd = rsqrtf(__hip_atomic_load(rowss + row, __ATOMIC_RELAXED, __HIP_MEMORY_SCOPE_AGENT) * (1.f / 1024.f) + EPS);
#pragma unroll
                for (int bj = 0; bj < 2; ++bj) {
                    const int c = col0 + bj * 128;
                    const f32x4 w0 = *(const f32x4*)(nw + c), w1 = *(const f32x4*)(nw + c + 4);
                    float* op = out + (size_t)row * D + c;
                    *(f32x4*)op = acc[ai][bj][m][0] * rstd * w0; *(f32x4*)(op + 4) = acc[ai][bj][m][1] * rstd * w1;
                }
            }
    }
};

enum { SK_GATES = 0, SK_OUT = 1, SK_UP = 2, SK_DOWN = 3 };
template <int MODE>
__device__ __forceinline__ void skinny(const Params& p, const h16* A, int lda, int row0, int nrt, const h16* Bt, int K, int nct) {
    const int lane = threadIdx.x & 63, wave = threadIdx.x >> 6, fr = lane & 15, fq = lane >> 4;
    const int gw = blockIdx.x * 8 + wave, ngw = gridDim.x * 8;
    unsigned char* ws = p.ws;
    for (int task = gw; task < nrt * nct; task += ngw) {
        const int rt = task % nrt, ct = task / nrt;
        const h16* ap = A + (size_t)(row0 + rt * 16 + fr) * lda + fq * 8;
        const h16* bp = Bt + (size_t)(ct * 16 + fr) * K + fq * 8;
        f32x4 acc = {0.f, 0.f, 0.f, 0.f};
#pragma unroll 8
        for (int k = 0; k < K; k += 32) { const h16x8 a = *(const h16x8*)(ap + k); const h16x8 b = *(const h16x8*)(bp + k); acc = mfma16(b, a, acc); }
        const int row = row0 + rt * 16 + fr, col = ct * 16 + fq * 4;
        if (MODE == SK_GATES) {
            const float* bi = p.in[12]; const float* bf = p.in[13];
            f32x4 o;
#pragma unroll
            for (int r = 0; r < 4; ++r) { const int cc = col + r; o[r] = acc[r] + (cc < 8 ? bi[cc] : bf[cc - 8]); }
            *(f32x4*)((float*)(ws + OFF_GATES) + (size_t)row * 16 + col) = o;
        } else if (MODE == SK_OUT) {
            const int s = row - MP;
            f32x4 v = acc + *(const f32x4*)(p.in[1] + (size_t)s * D + col);
            *(f32x4*)((float*)(ws + OFF_X1) + (size_t)row * D + col) = v;
            *(h16x4*)((h16*)(ws + OFF_X116) + (size_t)row * D + col) = pack4(v);
            float ss = v[0] * v[0] + v[1] * v[1] + v[2] * v[2] + v[3] * v[3];
            ss += __shfl_xor(ss, 16); ss += __shfl_xor(ss, 32);
            if (fq == 0) atomicAdd((float*)(ws + OFF_SS1) + row, ss);
        } else if (MODE == SK_UP) {
            const float rstd = rsqrtf(((const float*)(ws + OFF_SS1))[row] * (1.f / 1024.f) + EPS);
            f32x4 v;
#pragma unroll
            for (int r = 0; r < 4; ++r) { const float a = fmaxf(acc[r] * rstd, 0.f); v[r] = a * a; }
            *(h16x4*)((h16*)(ws + OFF_HID16) + (size_t)row * DFF + col) = pack4(v);
        } else {
            const int s = row - MP;
            f32x4 v = acc + *(const f32x4*)((const float*)(ws + OFF_X1) + (size_t)row * D + col);
            *(f32x4*)(p.out + O_YS + (size_t)s * D + col) = v;
            float ss = v[0] * v[0] + v[1] * v[1] + v[2] * v[2] + v[3] * v[3];
            ss += __shfl_xor(ss, 16); ss += __shfl_xor(ss, 32);
            if (fq == 0) atomicAdd((float*)(ws + OFF_SS2) + row, ss);
        }
    }
}

__device__ __forceinline__ void skinny_down_splitk(const Params& p, LAS unsigned char* lds) {
    unsigned char* ws = p.ws;
    LAS float* RED = (LAS float*)lds;
    const int lane = threadIdx.x & 63, wave = threadIdx.x >> 6, fr = lane & 15, fq = lane >> 4, grp = wave >> 2, ksp = wave & 3;
    const h16* A = (const h16*)(ws + OFF_HID16); const h16* Bt = (const h16*)(ws + OFF_WT_DN);
    constexpr int NRT = MS / 16, NCT = D / 16;
    for (int t0 = blockIdx.x * 2; t0 < NRT * NCT; t0 += gridDim.x * 2) {
        const int task = t0 + grp;
        const bool act = task < NRT * NCT;
        const int rt = act ? task % NRT : 0, ct = act ? task / NRT : 0;
        const h16* ap = A + (size_t)(MP + rt * 16 + fr) * DFF + ksp * 1024 + fq * 8;
        const h16* bp = Bt + (size_t)(ct * 16 + fr) * DFF + ksp * 1024 + fq * 8;
        f32x4 acc = {0.f, 0.f, 0.f, 0.f};
#pragma unroll 8
        for (int k = 0; k < 1024; k += 32) { const h16x8 a = *(const h16x8*)(ap + k); const h16x8 b = *(const h16x8*)(bp + k); acc = mfma16(b, a, acc); }
        *(LAS f32x4*)(RED + ((grp * 4 + ksp) * 64 + lane) * 4) = acc;
        __syncthreads();
        if (ksp == 0 && act) {
#pragma unroll
            for (int q = 1; q < 4; ++q) acc += *(const LAS f32x4*)(RED + ((grp * 4 + q) * 64 + lane) * 4);
            const int row = MP + rt * 16 + fr, col = ct * 16 + fq * 4, sidx = row - MP;
            f32x4 v = acc + *(const f32x4*)((const float*)(ws + OFF_X1) + (size_t)row * D + col);
            *(f32x4*)(p.out + O_YS + (size_t)sidx * D + col) = v;
            float ss = v[0] * v[0] + v[1] * v[1] + v[2] * v[2] + v[3] * v[3];
            ss += __shfl_xor(ss, 16); ss += __shfl_xor(ss, 32);
            if (fq == 0) atomicAdd((float*)(ws + OFF_SS2) + row, ss);
        }
        __syncthreads();
    }
}

__device__ __forceinline__ void tr_tile(const float* W, int K, int N, int kt, int nt, LAS float* tile, const float* kscale, h16* dst, int mode, h16* dstG) {
    const int tid = threadIdx.x, k0 = kt * 64, n0 = nt * 64;
    {
        const int kr = tid >> 4, nc = (tid & 15) * 4;
#pragma unroll
        for (int i = 0; i < 2; ++i) {
            const int k = kr + 32 * i;
            f32x4 v = {0.f, 0.f, 0.f, 0.f};
            if (n0 + nc < N) v = *(const f32x4*)(W + (size_t)(k0 + k) * N + n0 + nc);
            const float s = kscale ? kscale[k0 + k] : 1.f;
            tile[k * 65 + nc] = v[0] * s; tile[k * 65 + nc + 1] = v[1] * s; tile[k * 65 + nc + 2] = v[2] * s; tile[k * 65 + nc + 3] = v[3] * s;
        }
    }
    __syncthreads();
    {
        const int n = tid >> 3, kc = (tid & 7) * 8, gn = n0 + n;
        if (gn < N) {
            h16x8 o;
#pragma unroll
            for (int j = 0; j < 8; ++j) o[j] = (h16)tile[(kc + j) * 65 + n];
            h16* d;
            if (mode == 0) d = dst + (size_t)gn * K;
            else d = (gn < 2048) ? dst + (size_t)gn * K : (gn < 2064 ? dstG + (size_t)(gn - 2048) * K : dst + (size_t)(gn - 16) * K);
            *(h16x8*)(d + k0 + kc) = o;
        }
    }
    __syncthreads();
}

__device__ __forceinline__ void p0_prep(const Params& p, LAS unsigned char* lds) {
    unsigned char* ws = p.ws;
    LAS float* tile = (LAS float*)lds;
    for (int i = blockIdx.x * 512 + threadIdx.x; i < (MPAD - MALL) * D / 8; i += gridDim.x * 512) ((u32x4*)(ws + OFF_XN16 + (size_t)MALL * D * 2))[i] = (u32x4){0u, 0u, 0u, 0u};
    for (int i = blockIdx.x * 512 + threadIdx.x; i < 2 * MPAD; i += gridDim.x * 512) ((float*)(ws + OFF_SS1))[i] = 0.f;
    if (blockIdx.x == 0 && threadIdx.x < 64) ((unsigned*)(ws + OFF_CNT))[threadIdx.x] = 0u;
    constexpr int I_IN = 16 * 61, I_LW = 8, I_LA = 8, I_LG = 16;
    constexpr int NIT = I_IN + I_LW + I_LA + I_LG;
    for (int it = blockIdx.x; it < NIT; it += gridDim.x) {
        int r = it;
        if (r < I_IN) { tr_tile(p.in[9], 1024, 3856, r / 61, r % 61, tile, nullptr, (h16*)(ws + OFF_WT_IN), 1, (h16*)(ws + OFF_WT_G)); continue; } r -= I_IN;
        if (r < I_LW) { tr_tile(p.in[17], 64, 512, 0, r, tile, nullptr, (h16*)(ws + OFF_LW), 0, nullptr); continue; } r -= I_LW;
        if (r < I_LA) { tr_tile(p.in[19], 64, 512, 0, r, tile, nullptr, (h16*)(ws + OFF_LA), 0, nullptr); continue; } r -= I_LA;
        tr_tile(p.in[20], 128, 512, r / 8, r % 8, tile, nullptr, (h16*)(ws + OFF_LG), 0, nullptr);
    }
    const int lane = threadIdx.x & 63, wave = threadIdx.x >> 6;
    const float* nw = p.in[8];
    {
        f32x4 w4[4];
#pragma unroll
        for (int j = 0; j < 4; ++j) w4[j] = *(const f32x4*)(nw + lane * 4 + 256 * j);
        const int stride = gridDim.x * 8;
        for (int row = blockIdx.x * 8 + wave; row < MALL; row += 4 * stride) {
            f32x4 v[4][4]; float sq[4];
#pragma unroll
            for (int u = 0; u < 4; ++u) {
                const int r = row + u * stride, rc = r < MALL ? r : row;
                const float* xr = (rc < MP) ? p.in[0] + (size_t)rc * D : p.in[1] + (size_t)(rc - MP) * D;
                sq[u] = 0.f;
#pragma unroll
                for (int j = 0; j < 4; ++j) v[u][j] = *(const f32x4*)(xr + lane * 4 + 256 * j);
            }
#pragma unroll
            for (int u = 0; u < 4; ++u) {
#pragma unroll
                for (int j = 0; j < 4; ++j) sq[u] += v[u][j][0] * v[u][j][0] + v[u][j][1] * v[u][j][1] + v[u][j][2] * v[u][j][2] + v[u][j][3] * v[u][j][3];
                const float rstd = rsqrtf(wave_sum(sq[u]) * (1.f / D) + EPS);
                const int r = row + u * stride;
                if (r < MALL) {
                    h16* o = (h16*)(ws + OFF_XN16) + (size_t)r * D;
#pragma unroll
                    for (int j = 0; j < 4; ++j) *(h16x4*)(o + lane * 4 + 256 * j) = pack4(v[u][j] * rstd * w4[j]);
                }
            }
        }
    }
}

__device__ __forceinline__ float softplusf_(float z) { return fmaxf(z, 0.f) + __logf(1.f + __expf(-fabsf(z))); }
__device__ __forceinline__ void rwkv_prep_tile(const Params& p, LAS unsigned char* lds, int tile) {
    unsigned char* ws = p.ws;
    LAS h16* RS = (LAS h16*)lds;
    const int tid = threadIdx.x, lane = tid & 63, wave = tid >> 6, fr = lane & 15, fq = lane >> 4;
    const h16* PROJ = (const h16*)(ws + OFF_PROJ16);
    const float* mu = p.in[15];
    const int row0 = tile * 32;
    const int h = wave;
    const h16* LW = (const h16*)(ws + OFF_LW); const h16* LA = (const h16*)(ws + OFF_LA); const h16* LG = (const h16*)(ws + OFF_LG);
    auto finish_item = [&](const h16x8 cur, const float (&prev)[8], const f32x4 m0, const f32x4 m1, int i, int row, int c) {
        h16x8 o;
        const bool is_tanh = (c >= 1536 && c < 1600), is_sig = (c >= 1664);
        const float act_scale = is_tanh ? 2.f : 1.f;
#pragma unroll
        for (int j = 0; j < 8; ++j) {
            const float pj = (float)cur[j], mj = j < 4 ? m0[j] : m1[j - 4];
            float rs = pj + mj * (prev[j] - pj);
            const float sg = sigm(act_scale * rs);
            rs = is_tanh ? 2.f * sg - 1.f : (is_sig ? sg : rs);
            o[j] = (h16)rs;
        }
        *(LAS h16x8*)(RS + i * 1800 + c) = o;
        float* so = nullptr;
        if (row < MP) { if ((row & (SEQ - 1)) == SEQ - 1) so = p.out + O_PSH + (size_t)(row >> 11) * RWW + c; }
        else so = p.out + O_SSH + (size_t)(row - MP) * RWW + c;
        if (so) {
            f32x4 a, b;
#pragma unroll
            for (int j = 0; j < 4; ++j) { a[j] = (float)cur[j]; b[j] = (float)cur[4 + j]; }
            *(f32x4*)so = a; *(f32x4*)(so + 4) = b;
        }
    };
    if (row0 < MP) {
#pragma unroll 1
        for (int half = 0; half < 4; ++half) {
            h16x8 cur[4], pv[4];
#pragma unroll
            for (int k = 0; k < 4; ++k) {
                const int kk = (half * 4 + k) < 14 ? (half * 4 + k) : 13;
                const int it = tid + 512 * kk, i = it / 224, g = it - i * 224, row = row0 + i, c = g * 8;
                const int prow = (row & (SEQ - 1)) ? row - 1 : row;
                cur[k] = *(const h16x8*)(PROJ + (size_t)row * NPROJ + 2048 + c);
                pv[k] = *(const h16x8*)(PROJ + (size_t)prow * NPROJ + 2048 + c);
            }
#pragma unroll
            for (int k = 0; k < 4; ++k) {
                if (half * 4 + k >= 14) break;
                const int it = tid + 512 * (half * 4 + k), i = it / 224, g = it - i * 224, row = row0 + i, c = g * 8;
                const bool first = (row & (SEQ - 1)) == 0;
                float prev[8];
#pragma unroll
                for (int j = 0; j < 8; ++j) prev[j] = first ? 0.f : (float)pv[k][j];
                finish_item(cur[k], prev, *(const f32x4*)(mu + c), *(const f32x4*)(mu + c + 4), i, row, c);
            }
        }
    } else {
        for (int it = tid; it < 32 * 224; it += 512) {
            const int i = it / 224, g = it % 224, row = row0 + i, c = g * 8;
            const h16x8 cur = *(const h16x8*)(PROJ + (size_t)row * NPROJ + 2048 + c);
            float prev[8];
            const float* sh = p.in[7] + (size_t)(row - MP) * RWW + c;
            const f32x4 a = *(const f32x4*)sh, b = *(const f32x4*)(sh + 4);
#pragma unroll
            for (int j = 0; j < 4; ++j) { prev[j] = a[j]; prev[4 + j] = b[j]; }
            finish_item(cur, prev, *(const f32x4*)(mu + c), *(const f32x4*)(mu + c + 4), i, row, c);
        }
    }
    __syncthreads();
    f32x4 accW[2][4], accA[2][4], accG[2][4];
#pragma unroll
    for (int rt = 0; rt < 2; ++rt)
#pragma unroll
        for (int ct = 0; ct < 4; ++ct) { accW[rt][ct] = (f32x4){0.f, 0.f, 0.f, 0.f}; accA[rt][ct] = accW[rt][ct]; accG[rt][ct] = accW[rt][ct]; }
#pragma unroll
    for (int ks = 0; ks < 2; ++ks) {
        h16x8 aw[2], aa[2];
#pragma unroll
        for (int rt = 0; rt < 2; ++rt) { aw[rt] = *(const LAS h16x8*)(RS + (rt * 16 + fr) * 1800 + 1536 + ks * 32 + fq * 8); aa[rt] = *(const LAS h16x8*)(RS + (rt * 16 + fr) * 1800 + 1600 + ks * 32 + fq * 8); }
        h16x8 bw[4], ba[4];
#pragma unroll
        for (int ct = 0; ct < 4; ++ct) {
            bw[ct] = *(const h16x8*)(LW + (size_t)(h * 64 + ct * 16 + fr) * 64 + ks * 32 + fq * 8);
            ba[ct] = *(const h16x8*)(LA + (size_t)(h * 64 + ct * 16 + fr) * 64 + ks * 32 + fq * 8);
        }
#pragma unroll
        for (int ct = 0; ct < 4; ++ct)
#pragma unroll
            for (int rt = 0; rt < 2; ++rt) { accW[rt][ct] = mfma16(bw[ct], aw[rt], accW[rt][ct]); accA[rt][ct] = mfma16(ba[ct], aa[rt], accA[rt][ct]); }
    }
#pragma unroll
    for (int ks = 0; ks < 4; ++ks) {
        h16x8 ag[2];
#pragma unroll
        for (int rt = 0; rt < 2; ++rt) ag[rt] = *(const LAS h16x8*)(RS + (rt * 16 + fr) * 1800 + 1664 + ks * 32 + fq * 8);
        h16x8 bg[4];
#pragma unroll
        for (int ct = 0; ct < 4; ++ct) bg[ct] = *(const h16x8*)(LG + (size_t)(h * 64 + ct * 16 + fr) * 128 + ks * 32 + fq * 8);
#pragma unroll
        for (int ct = 0; ct < 4; ++ct)
#pragma unroll
            for (int rt = 0; rt < 2; ++rt) accG[rt][ct] = mfma16(bg[ct], ag[rt], accG[rt][ct]);
    }
    h16* OPS = (h16*)(ws + OFF_OPS16);
    h16* G16 = (h16*)((unsigned char*)p.out + OUTB_G16);
    float* RKS = (float*)(ws + OFF_RKS);
    float ss[2] = {0.f, 0.f}, rks[2] = {0.f, 0.f}, inv[2];
#pragma unroll
    for (int ct = 0; ct < 4; ++ct) {
        const int col = h * 64 + ct * 16 + fq * 4;
        const f32x4 kkw = *(const f32x4*)(p.in[21] + col);
#pragma unroll
        for (int rt = 0; rt < 2; ++rt) {
            const h16x4 k4 = *(const LAS h16x4*)(RS + (rt * 16 + fr) * 1800 + 512 + col);
#pragma unroll
            for (int r = 0; r < 4; ++r) { const float kk = (float)k4[r] * kkw[r]; ss[rt] += kk * kk; }
        }
    }
#pragma unroll
    for (int rt = 0; rt < 2; ++rt) {
        float s1 = ss[rt];
        s1 += __shfl_xor(s1, 16); s1 += __shfl_xor(s1, 32);
        inv[rt] = 1.f / fmaxf(sqrtf(s1), 1e-12f);
    }
#pragma unroll
    for (int ct = 0; ct < 4; ++ct) {
        const int c64 = ct * 16 + fq * 4, col = h * 64 + c64;
        const f32x4 w0 = *(const f32x4*)(p.in[16] + col), a0 = *(const f32x4*)(p.in[18] + col), kkw = *(const f32x4*)(p.in[21] + col),
                    kaw = *(const f32x4*)(p.in[22] + col), rkw = *(const f32x4*)(p.in[23] + col);
#pragma unroll
        for (int rt = 0; rt < 2; ++rt) {
            const int i = rt * 16 + fr, row = row0 + i;
            h16* ob = OPS + ((size_t)row * 8 + h) * 6 * 64;
            const h16x4 r4 = *(const LAS h16x4*)(RS + i * 1800 + col);
            const h16x4 k4 = *(const LAS h16x4*)(RS + i * 1800 + 512 + col);
            const h16x4 v4 = *(const LAS h16x4*)(RS + i * 1800 + 1024 + col);
            f32x4 wl, ke, na, nb;
#pragma unroll
            for (int r = 0; r < 4; ++r) {
                const float wraw = w0[r] + accW[rt][ct][r];
                wl[r] = -__expf(-softplusf_(-wraw) - 0.5f);
                const float a = sigm(a0[r] + accA[rt][ct][r]);
                const float kf = (float)k4[r], kn = kf * kkw[r] * inv[rt];
                na[r] = -kn; nb[r] = kn * a;
                ke[r] = kf * (1.f + (a - 1.f) * kaw[r]);
                rks[rt] += (float)r4[r] * ke[r] * rkw[r];
            }
            *(h16x4*)(ob + 0 * 64 + c64) = r4;
            *(h16x4*)(ob + 1 * 64 + c64) = pack4(wl);
            *(h16x4*)(ob + 2 * 64 + c64) = pack4(ke);
            *(h16x4*)(ob + 3 * 64 + c64) = v4;
            *(h16x4*)(ob + 4 * 64 + c64) = pack4(na);
            *(h16x4*)(ob + 5 * 64 + c64) = pack4(nb);
            *(h16x4*)(G16 + (size_t)row * 512 + col) = pack4(accG[rt][ct]);
        }
        __builtin_amdgcn_sched_barrier(0);
    }
#pragma unroll
    for (int rt = 0; rt < 2; ++rt) {
        const int row = row0 + rt * 16 + fr;
        float s2 = rks[rt];
        s2 += __shfl_xor(s2, 16); s2 += __shfl_xor(s2, 32);
        if (fq == 0) RKS[(size_t)row * 8 + h] = s2;
    }
    __syncthreads();
}

struct MlChain { int rowbase, T, h; const float* C0; const float* n0; const float* m0; const float* conv0; float* Cout; float* nout; float* mout; float* convout; };
typedef _Float16 h16x2 __attribute__((ext_vector_type(2)));
__device__ __forceinline__ void mlstm_chain(const Params& p, LAS unsigned char* lds, const MlChain ch) {
    unsigned char* ws = p.ws;
    LAS h16* XQ = (LAS h16*)lds;
    LAS h16* QS = (LAS h16*)(lds + 18432);
    LAS h16* KS = QS + 64 * 72; LAS h16* VT = KS + 64 * 72; LAS h16* KW = VT + 64 * 72; LAS h16* PP = KW + 64 * 72; LAS h16* CT = PP + 64 * 72;
    LAS float* SCL = (LAS float*)(lds + 73728);
    LAS float* DEN = SCL; LAS float* SSQ = SCL + 128; LAS float* NL = SCL + 256; LAS float* DQN = SCL + 320;
    LAS float* CBC = (LAS float*)(lds + 75264); LAS float* CUU = CBC + 2048; LAS float* CCM = CUU + 2048; LAS float* CBE = CCM + 2048; LAS float* CGM = CBE + 32;
    const int tid = threadIdx.x, lane = tid & 63, wave = tid >> 6, fr = lane & 15, fq = lane >> 4;
    const int h = ch.h, T = ch.T, rowbase = ch.rowbase;
    const h16* PROJ = (const h16*)(ws + OFF_PROJ16);
    const float* GATES = (const float*)(ws + OFF_GATES);
    h16* MIX = (h16*)((unsigned char*)p.out + OUTB_MIX16);
    const int kt = wave & 3;
    f32x4 Cacc[2];
#pragma unroll
    for (int j = 0; j < 2; ++j) {
        const int vt = (wave >> 2) * 2 + j;
#pragma unroll
        for (int r = 0; r < 4; ++r) Cacc[j][r] = ch.C0 ? ch.C0[(size_t)(kt * 16 + fq * 4 + r) * 64 + vt * 16 + fr] : 0.f;
    }
    const float n0v = (tid < 64 && ch.n0) ? ch.n0[tid] : 0.f;
    float mcur = ch.m0 ? ch.m0[0] : 0.f;
    const int cg8 = tid & 15, gcol0 = (cg8 < 8) ? h * 64 + cg8 * 8 : 512 + h * 64 + (cg8 - 8) * 8;
    float cw[4][8], cbv[8];
#pragma unroll
    for (int j = 0; j < 4; ++j) {
        const f32x4 w0 = *(const f32x4*)(p.in[10] + j * 1024 + gcol0), w1 = *(const f32x4*)(p.in[10] + j * 1024 + gcol0 + 4);
#pragma unroll
        for (int e = 0; e < 4; ++e) { cw[j][e] = w0[e]; cw[j][4 + e] = w1[e]; }
    }
    {
        const f32x4 b0 = *(const f32x4*)(p.in[11] + gcol0), b1 = *(const f32x4*)(p.in[11] + gcol0 + 4);
#pragma unroll
        for (int e = 0; e < 4; ++e) { cbv[e] = b0[e]; cbv[4 + e] = b1[e]; }
    }
    const int nchunks = (T + 63) >> 6;
    for (int cc = wave; cc < nchunks; cc += 8) {
        const int tok = cc * 64 + lane;
        float ig = -INFINITY, lf = 0.f;
        if (tok < T) { const float* gp = GATES + (size_t)(rowbase + tok) * 16; ig = gp[h]; const float f = gp[8 + h]; lf = fminf(f, 0.f) - log1pf(__expf(-fabsf(f))); }
        float bc = lf;
#pragma unroll
        for (int o = 1; o < 64; o <<= 1) { const float t = __shfl_up(bc, o); if (lane >= o) bc += t; }
        const float u = ig - bc;
        float cm = u;
#pragma unroll
        for (int o = 1; o < 64; o <<= 1) { const float t = __shfl_up(cm, o); if (lane >= o) cm = fmaxf(cm, t); }
        const float bend = __shfl(bc, 63);
        const float gmax = wave_max(bend + u);
        CBC[cc * 64 + lane] = bc; CUU[cc * 64 + lane] = u; CCM[cc * 64 + lane] = cm;
        if (lane == 0) { CBE[cc] = bend; CGM[cc] = gmax; }
    }
    h16x8 pxq[3], pvv; h16x4 po[2];
    auto issue_loads = [&](int c) {
        const int t0 = c * 64, nv = (T - t0) < 64 ? (T - t0) : 64;
#pragma unroll
        for (int k = 0; k < 3; ++k) {
            const int it = tid + 512 * k;
            h16x8 v;
#pragma unroll
            for (int j = 0; j < 8; ++j) v[j] = (h16)0.f;
            if (it < 67 * 16) {
                const int i = it >> 4, g = it & 15, tok = t0 - 3 + i, c8 = g * 8;
                const int srccol = (g < 8) ? h * 64 + c8 : 512 + h * 64 + (c8 - 64);
                if (tok >= 0 && tok < T) v = *(const h16x8*)(PROJ + (size_t)(rowbase + tok) * NPROJ + srccol);
                else if (tok < 0 && ch.conv0) {
                    const float* cp = ch.conv0 + (size_t)(3 + tok) * 1024 + srccol;
#pragma unroll
                    for (int j = 0; j < 8; ++j) v[j] = (h16)cp[j];
                }
            }
            pxq[k] = v;
        }
        {
            const int s = tid & 63, g = tid >> 6;
            h16x8 v;
#pragma unroll
            for (int j = 0; j < 8; ++j) v[j] = (h16)0.f;
            if (s < nv) v = *(const h16x8*)(PROJ + (size_t)(rowbase + t0 + s) * NPROJ + 1024 + h * 64 + g * 8);
            pvv = v;
        }
        {
            const int t = (wave & 3) * 16 + fr;
#pragma unroll
            for (int j = 0; j < 2; ++j) {
                h16x4 o4;
#pragma unroll
                for (int r = 0; r < 4; ++r) o4[r] = (h16)0.f;
                if (t < nv) o4 = *(const h16x4*)(PROJ + (size_t)(rowbase + t0 + t) * NPROJ + 1536 + h * 64 + ((wave >> 2) * 2 + j) * 16 + fq * 4);
                po[j] = o4;
            }
        }
    };
    issue_loads(0);
#pragma unroll
    for (int j = 0; j < 2; ++j) *(LAS h16x4*)(CT + (((wave >> 2) * 2 + j) * 16 + fr) * 72 + kt * 16 + fq * 4) = pack4(Cacc[j]);
    if (tid < 64) NL[tid] = n0v;
    __syncthreads();
    for (int c = 0; c < nchunks; ++c) {
        const int t0 = c * 64, nv = (T - t0) < 64 ? (T - t0) : 64;
#pragma unroll
        for (int k = 0; k < 3; ++k) {
            const int it = tid + 512 * k;
            if (it < 67 * 16) *(LAS h16x8*)(XQ + (it >> 4) * 136 + (it & 15) * 8) = pxq[k];
        }
        {
            const int s = tid & 63, g = tid >> 6;
#pragma unroll
            for (int j = 0; j < 8; ++j) VT[(g * 8 + j) * 72 + s] = pvv[j];
        }
        const h16x4 oc0 = po[0], oc1 = po[1];
        const float bendc = CBE[c], mnew = fmaxf(bendc + mcur, CGM[c]), dec = __expf(bendc + mcur - mnew);
        lds_barrier();
        if (c + 1 < nchunks) issue_loads(c + 1);
        {
            const int s0 = (tid >> 4) * 2;
            h16x8 x[5];
#pragma unroll
            for (int j = 0; j < 5; ++j) x[j] = *(const LAS h16x8*)(XQ + (s0 + j) * 136 + cg8 * 8);
            float kw[2][8];
#pragma unroll
            for (int tk = 0; tk < 2; ++tk) {
                const int s = s0 + tk;
                h16x8 yo;
                float wsv = 0.f;
                if (cg8 >= 8) wsv = 0.125f * __expf(bendc + CUU[c * 64 + s] - mnew);
#pragma unroll
                for (int e = 0; e < 8; ++e) {
                    const float a = cbv[e] + (float)x[tk][e] * cw[0][e] + (float)x[tk + 1][e] * cw[1][e] + (float)x[tk + 2][e] * cw[2][e] + (float)x[tk + 3][e] * cw[3][e];
                    const float y = a * __builtin_amdgcn_rcpf(1.f + __expf(-a));
                    yo[e] = (h16)(cg8 < 8 ? y : 0.125f * y);
                    kw[tk][e] = y * wsv;
                }
                if (cg8 < 8) *(LAS h16x8*)(QS + s * 72 + cg8 * 8) = yo;
                else *(LAS h16x8*)(KS + s * 72 + (cg8 - 8) * 8) = yo;
            }
            if (cg8 >= 8) {
#pragma unroll
                for (int e = 0; e < 8; ++e) { h16x2 w2; w2[0] = (h16)kw[0][e]; w2[1] = (h16)kw[1][e]; *(LAS h16x2*)(KW + ((cg8 - 8) * 8 + e) * 72 + s0) = w2; }
            }
        }
        lds_barrier();
        {
            const int tt = wave & 3, sp = wave >> 2;
            h16x8 qa[2];
#pragma unroll
            for (int ks = 0; ks < 2; ++ks) qa[ks] = *(const LAS h16x8*)(QS + (tt * 16 + fr) * 72 + ks * 32 + fq * 8);
            float mx[4];
#pragma unroll
            for (int r = 0; r < 4; ++r) mx[r] = fmaxf(mcur, CCM[c * 64 + tt * 16 + fq * 4 + r]);
            float dpart[4] = {0.f, 0.f, 0.f, 0.f};
#pragma unroll
            for (int j = 0; j < 2; ++j) {
                const int st = sp * 2 + j;
                f32x4 acc = {0.f, 0.f, 0.f, 0.f};
#pragma unroll
                for (int ks = 0; ks < 2; ++ks) { const h16x8 kb = *(const LAS h16x8*)(KS + (st * 16 + fr) * 72 + ks * 32 + fq * 8); acc = mfma16(qa[ks], kb, acc); }
                const int s = st * 16 + fr; const float us = CUU[c * 64 + s];
#pragma unroll
                for (int r = 0; r < 4; ++r) {
                    const int t = tt * 16 + fq * 4 + r;
                    const float wgt = (s <= t) ? __expf(us - mx[r]) : 0.f;
                    const float pv = acc[r] * wgt; dpart[r] += pv; PP[t * 72 + s] = (h16)pv;
                }
            }
#pragma unroll
            for (int r = 0; r < 4; ++r) {
                float d = dpart[r]; d = row_sum16(d);
                if (fr == 0) DEN[sp * 64 + tt * 16 + fq * 4 + r] = d;
            }
            const int t = tid >> 3, part = tid & 7;
            const h16x8 q8 = *(const LAS h16x8*)(QS + t * 72 + part * 8);
            const f32x4 n0 = *(const LAS f32x4*)(NL + part * 8), n1 = *(const LAS f32x4*)(NL + part * 8 + 4);
            float a = 0.f;
#pragma unroll
            for (int j = 0; j < 4; ++j) a += (float)q8[j] * n0[j] + (float)q8[4 + j] * n1[j];
            a = dpp_add<0xB1>(a); a = dpp_add<0x4E>(a); a += __shfl_xor(a, 4);
            if (part == 0) DQN[t] = a;
        }
        lds_barrier();
        {
            const int tt = wave & 3, vp = wave >> 2, t = tt * 16 + fr;
            h16x8 pa[2], qa[2];
#pragma unroll
            for (int ks = 0; ks < 2; ++ks) { pa[ks] = *(const LAS h16x8*)(PP + t * 72 + ks * 32 + fq * 8); qa[ks] = *(const LAS h16x8*)(QS + t * 72 + ks * 32 + fq * 8); }
            const float mxt = fmaxf(mcur, CCM[c * 64 + t]);
            const float sc = __expf(mcur - mxt);
            const float den = DEN[t] + DEN[64 + t] + sc * DQN[t];
            const float inv = 1.f / fmaxf(fabsf(den), __expf(-(CBC[c * 64 + t] + mxt)));
            float hv[2][4], ssq = 0.f;
#pragma unroll
            for (int j = 0; j < 2; ++j) {
                const int vt = vp * 2 + j;
                f32x4 a1 = {0.f, 0.f, 0.f, 0.f}, a2 = {0.f, 0.f, 0.f, 0.f};
#pragma unroll
                for (int ks = 0; ks < 2; ++ks) {
                    const h16x8 vb = *(const LAS h16x8*)(VT + (vt * 16 + fr) * 72 + ks * 32 + fq * 8);
                    const h16x8 cbf = *(const LAS h16x8*)(CT + (vt * 16 + fr) * 72 + ks * 32 + fq * 8);
                    a1 = mfma16(vb, pa[ks], a1); a2 = mfma16(cbf, qa[ks], a2);
                }
                const h16x4 o4 = j == 0 ? oc0 : oc1;
#pragma unroll
                for (int r = 0; r < 4; ++r) { const float hh = (a1[r] + sc * a2[r]) * inv * sigm((float)o4[r]); hv[j][r] = hh; ssq += hh * hh; }
            }
            ssq += __shfl_xor(ssq, 16); ssq += __shfl_xor(ssq, 32);
            if (fq == 0) SSQ[vp * 64 + t] = ssq;
            lds_barrier();
            const float rstd = rsqrtf((SSQ[t] + SSQ[64 + t]) * (1.f / 64.f) + EPS);
            if (t < nv) {
#pragma unroll
                for (int j = 0; j < 2; ++j) {
                    const int v0 = h * 64 + (vp * 2 + j) * 16 + fq * 4;
                    const f32x4 nw = *(const f32x4*)(p.in[14] + v0);
                    f32x4 o;
#pragma unroll
                    for (int r = 0; r < 4; ++r) o[r] = hv[j][r] * rstd * nw[r];
                    *(h16x4*)(MIX + (size_t)(rowbase + t0 + t) * D + v0) = pack4(o);
                }
            }
        }
        {
#pragma unroll
            for (int j = 0; j < 2; ++j) {
                const int vt = (wave >> 2) * 2 + j;
                Cacc[j] *= dec;
#pragma unroll
                for (int ks = 0; ks < 2; ++ks) {
                    const h16x8 kwf = *(const LAS h16x8*)(KW + (kt * 16 + fr) * 72 + ks * 32 + fq * 8);
                    const h16x8 vf = *(const LAS h16x8*)(VT + (vt * 16 + fr) * 72 + ks * 32 + fq * 8);
                    Cacc[j] = mfma16(kwf, vf, Cacc[j]);
                }
                *(LAS h16x4*)(CT + (vt * 16 + fr) * 72 + kt * 16 + fq * 4) = pack4(Cacc[j]);
            }
            {
                const int kch = tid >> 3, part = tid & 7;
                const h16x8 x = *(const LAS h16x8*)(KW + kch * 72 + part * 8);
                float a = 0.f;
#pragma unroll
                for (int j = 0; j < 8; ++j) a += (float)x[j];
                a = dpp_add<0xB1>(a); a = dpp_add<0x4E>(a); a += __shfl_xor(a, 4);
                if (part == 0) NL[kch] = dec * NL[kch] + a;
            }
            mcur = mnew;
        }
        lds_barrier();
    }
#pragma unroll
    for (int j = 0; j < 2; ++j) {
        const int vt = (wave >> 2) * 2 + j;
#pragma unroll
        for (int r = 0; r < 4; ++r) ch.Cout[(size_t)(kt * 16 + fq * 4 + r) * 64 + vt * 16 + fr] = Cacc[j][r];
    }
    if (tid < 64) ch.nout[tid] = NL[tid];
    if (tid == 0) ch.mout[0] = mcur;
    if (tid < 384) {
        const int j = tid >> 7, cc = tid & 127, gcol = (cc < 64) ? h * 64 + cc : 512 + h * 64 + (cc - 64), tk = T - 3 + j;
        float v = 0.f;
        if (tk >= 0) v = (float)PROJ[(size_t)(rowbase + tk) * NPROJ + gcol];
        else if (ch.conv0) v = ch.conv0[(size_t)(3 + tk) * 1024 + gcol];
        ch.convout[(size_t)j * 1024 + gcol] = v;
    }
    __syncthreads();
}

__device__ __forceinline__ void mlstm_sample_task(const Params& p, int s, int h) {
    unsigned char* ws = p.ws;
    const int lane = threadIdx.x & 63, row = MP + s, i = s * 8 + h;
    const h16* pr = (const h16*)(ws + OFF_PROJ16) + (size_t)row * NPROJ;
    const float* C0 = p.in[2] + (size_t)i * 4096;
    float c0[64];
#pragma unroll
    for (int k = 0; k < 64; ++k) c0[k] = C0[k * 64 + lane];
    const int gq = h * 64 + lane, gk = 512 + h * 64 + lane;
    const float* cv = p.in[5] + (size_t)s * 3072;
    const float q0 = cv[gq], q1 = cv[1024 + gq], q2 = cv[2048 + gq], q3 = (float)pr[gq];
    const float k0 = cv[gk], k1 = cv[1024 + gk], k2 = cv[2048 + gk], k3 = (float)pr[gk];
    const float vv = (float)pr[1024 + h * 64 + lane], op = (float)pr[1536 + h * 64 + lane];
    const float* cwp = p.in[10];
    const float qc = p.in[11][gq] + q0 * cwp[gq] + q1 * cwp[1024 + gq] + q2 * cwp[2048 + gq] + q3 * cwp[3072 + gq];
    const float kc = p.in[11][gk] + k0 * cwp[gk] + k1 * cwp[1024 + gk] + k2 * cwp[2048 + gk] + k3 * cwp[3072 + gk];
    const float q = qc * sigm(qc), kk = kc * sigm(kc) * 0.125f;
    float* co = p.out + O_SCONV + (size_t)s * 3072;
    co[gq] = q1; co[1024 + gq] = q2; co[2048 + gq] = q3;
    co[gk] = k1; co[1024 + gk] = k2; co[2048 + gk] = k3;
    const float* gp = (const float*)(ws + OFF_GATES) + (size_t)row * 16;
    const float ig = gp[h], fg = gp[8 + h];
    const float lf = fminf(fg, 0.f) - __logf(1.f + __expf(-fabsf(fg)));
    const float m0 = p.in[4][i], n0 = p.in[3][(size_t)i * 64 + lane];
    const float inter = lf + m0, mt = fmaxf(inter, ig), wts = __expf(ig - mt), sc = __expf(inter - mt);
    const float qk = wave_sum(q * kk) * wts, qn = wave_sum(q * n0);
    const float den = qk + sc * qn, inv = 1.f / fmaxf(fabsf(den), __expf(-mt));
    float qc_acc = 0.f;
    float* Co = p.out + O_SC + (size_t)i * 4096;
    const int qb = __builtin_bit_cast(int, q), kb = __builtin_bit_cast(int, kk);
#pragma unroll
    for (int k = 0; k < 64; ++k) {
        const float qk_ = __builtin_bit_cast(float, __builtin_amdgcn_readlane(qb, k)), kk_ = __builtin_bit_cast(float, __builtin_amdgcn_readlane(kb, k));
        qc_acc += qk_ * c0[k];
        Co[k * 64 + lane] = sc * c0[k] + (wts * kk_) * vv;
    }
    const float hh = (qk * vv + sc * qc_acc) * inv * sigm(op);
    const float rstd = rsqrtf(wave_sum(hh * hh) * (1.f / 64.f) + EPS);
    ((h16*)((unsigned char*)p.out + OUTB_MIX16))[(size_t)row * D + gq] = (h16)(hh * rstd * p.in[14][gq]);
    p.out[O_SN + (size_t)i * 64 + lane] = sc * n0 + wts * kk;
    if (lane == 0) p.out[O_SM + i] = mt;
}
__device__ __forceinline__ void late_transposes(const Params& p, LAS unsigned char* lds, int w, int nw) {
    unsigned char* ws = p.ws;
    LAS float* tile = (LAS float*)lds;
    constexpr int I_OUT = 16 * 16, I_UP = 16 * 64, I_DN = 64 * 16;
    for (int it = w; it < I_OUT + I_UP + I_DN; it += nw) {
        int r = it;
        if (r < I_OUT) { tr_tile(p.in[26], 1024, 1024, r / 16, r % 16, tile, nullptr, (h16*)(ws + OFF_WT_OUT), 0, nullptr); continue; } r -= I_OUT;
        if (r < I_UP) { tr_tile(p.in[28], 1024, 4096, r / 64, r % 64, tile, p.in[27], (h16*)(ws + OFF_WT_UP), 0, nullptr); continue; } r -= I_UP;
        tr_tile(p.in[29], 4096, 1024, r / 16, r % 16, tile, nullptr, (h16*)(ws + OFF_WT_DN), 0, nullptr);
    }
}
__device__ __forceinline__ void p2_mixprep(const Params& p, LAS unsigned char* lds) {
    const int nb = gridDim.x, bid = blockIdx.x;
    if (bid < 64) {
        const int b = bid >> 3, h = bid & 7;
        MlChain ch; ch.rowbase = b * SEQ; ch.T = SEQ; ch.h = h; ch.C0 = nullptr; ch.n0 = nullptr; ch.m0 = nullptr; ch.conv0 = nullptr;
        ch.Cout = p.out + O_PC + (size_t)bid * 4096; ch.nout = p.out + O_PN + (size_t)bid * 64; ch.mout = p.out + O_PM + bid; ch.convout = p.out + O_PCONV + (size_t)b * 3072;
        mlstm_chain(p, lds, ch);
        return;
    }
    const int w = bid - 64, nw = nb - 64;
    for (int tile = w; tile < MALL / 32; tile += nw) rwkv_prep_tile(p, lds, tile);
    for (int i = w * 8 + (int)(threadIdx.x >> 6); i < MS * 8; i += nw * 8) mlstm_sample_task(p, i >> 3, i & 7);
    __syncthreads();
    late_transposes(p, lds, w, nw);
}

__device__ __forceinline__ void rwkv_scan_prompt(const Params& p, LAS unsigned char* lds, int bh, int rq) {
    constexpr int TC = 32, NCH = SEQ / TC, NPIECE = TC * 48 / 256;
    unsigned char* ws = p.ws;
    LAS float* OPS = (LAS float*)lds;
    LAS float* RKB = (LAS float*)(lds + 2 * TC * 6 * 64 * 4);
    const int tid = threadIdx.x, lane = tid & 63, wave = tid >> 6;
    const int b = bh >> 3, h = bh & 7, rowbase = b * SEQ;
    const h16* OPSG = (const h16*)(ws + OFF_OPS16);
    const float* RKS = (const float*)(ws + OFF_RKS);
    float* YRAW = (float*)(ws + OFF_YRAW);
    const int rr = lane >> 4, cg_ = lane & 15, rloc = (wave & 3) * 4 + rr;
    const int ltid = tid - 256;
    f32x4 S = {0.f, 0.f, 0.f, 0.f};
    h16x8 pre[NPIECE]; float prk = 0.f;
    auto issue_chunk = [&](int c) {
#pragma unroll
        for (int i = 0; i < NPIECE; ++i) {
            const int piece = ltid + 256 * i, tk = piece / 48, q = piece % 48, vec = q >> 3, c8 = q & 7;
            pre[i] = *(const h16x8*)(OPSG + (((size_t)(rowbase + c * TC + tk) * 8 + h) * 6 + vec) * 64 + c8 * 8);
        }
        if (ltid < TC) prk = RKS[(size_t)(rowbase + c * TC + ltid) * 8 + h];
    };
    auto store_chunk = [&](int buf) {
#pragma unroll
        for (int i = 0; i < NPIECE; ++i) {
            const int piece = ltid + 256 * i, tk = piece / 48, q = piece % 48, vec = q >> 3, c8 = q & 7;
            const h16x8 v = pre[i];
            f32x4 a, bb;
#pragma unroll
            for (int j = 0; j < 4; ++j) { a[j] = (float)v[j]; bb[j] = (float)v[4 + j]; }
            if (vec == 1) {
#pragma unroll
                for (int j = 0; j < 4; ++j) { a[j] = __expf(a[j]); bb[j] = __expf(bb[j]); }
            }
            LAS float* d = OPS + ((buf * TC + tk) * 6 + vec) * 64 + c8 * 8;
            *(LAS f32x4*)d = a; *(LAS f32x4*)(d + 4) = bb;
        }
        if (ltid < TC) RKB[buf * TC + ltid] = prk;
    };
    if (wave >= 4) { issue_chunk(0); store_chunk(0); issue_chunk(1); }
    lds_barrier();
    for (int c = 0; c < NCH; ++c) {
        const int buf = c & 1;
        if (wave >= 4) {
            if (c + 1 < NCH) store_chunk(buf ^ 1);
            if (c + 2 < NCH) issue_chunk(c + 2);
        } else {
            float yk[TC / 16];
#pragma unroll
            for (int j = 0; j < TC / 16; ++j) yk[j] = 0.f;
            const LAS float* ob = OPS + buf * TC * 6 * 64;
            f32x4 r4 = *(const LAS f32x4*)(ob + cg_ * 4), d4 = *(const LAS f32x4*)(ob + 64 + cg_ * 4), k4 = *(const LAS f32x4*)(ob + 128 + cg_ * 4),
                  a4 = *(const LAS f32x4*)(ob + 256 + cg_ * 4), b4 = *(const LAS f32x4*)(ob + 320 + cg_ * 4);
            float vv = ob[192 + rq * 16 + rloc];
            f32x4 rp = r4;
#pragma unroll
            for (int tk = 0; tk < TC; ++tk) {
                f32x4 nr4 = r4, nd4 = d4, nk4 = k4, na4 = a4, nb4 = b4; float nvv = vv;
                if (tk < TC - 1) {
                    const LAS float* o = ob + (tk + 1) * 6 * 64;
                    nr4 = *(const LAS f32x4*)(o + cg_ * 4); nd4 = *(const LAS f32x4*)(o + 64 + cg_ * 4); nk4 = *(const LAS f32x4*)(o + 128 + cg_ * 4);
                    na4 = *(const LAS f32x4*)(o + 256 + cg_ * 4); nb4 = *(const LAS f32x4*)(o + 320 + cg_ * 4);
                    nvv = o[192 + rq * 16 + rloc];
                }
                __builtin_amdgcn_sched_barrier(0);
                typedef float f32x2_ __attribute__((ext_vector_type(2)));
                f32x2_ ta = (f32x2_){S[0], S[1]} * (f32x2_){a4[0], a4[1]}; ta = (f32x2_){S[2], S[3]} * (f32x2_){a4[2], a4[3]} + ta;
                f32x2_ ty = (f32x2_){S[0], S[1]} * (f32x2_){rp[0], rp[1]}; ty = (f32x2_){S[2], S[3]} * (f32x2_){rp[2], rp[3]} + ty;
                const f32x4 T = S * d4 + vv * k4;
                float sa = ta[0] + ta[1];
                float yp = ty[0] + ty[1];
                sa = dpp_add<0xB1>(sa); yp = dpp_add<0xB1>(yp);
                sa = dpp_add<0x4E>(sa); yp = dpp_add<0x4E>(yp);
                sa = dpp_add<0x124>(sa); yp = dpp_add<0x124>(yp);
                sa = dpp_add<0x128>(sa); yp = dpp_add<0x128>(yp);
                if (tk > 0) yk[(tk - 1) >> 4] = (cg_ == ((tk - 1) & 15)) ? yp : yk[(tk - 1) >> 4];
                S = sa * b4 + T;
                rp = r4;
                r4 = nr4; d4 = nd4; k4 = nk4; a4 = na4; b4 = nb4; vv = nvv;
            }
            {
                float yp = S[0] * rp[0] + S[1] * rp[1] + S[2] * rp[2] + S[3] * rp[3];
                yp = row_sum16(yp);
                yk[(TC - 1) >> 4] = (cg_ == ((TC - 1) & 15)) ? yp : yk[(TC - 1) >> 4];
            }
#pragma unroll
            for (int j = 0; j < TC / 16; ++j) yk[j] += RKB[buf * TC + j * 16 + cg_] * ob[(j * 16 + cg_) * 6 * 64 + 192 + rq * 16 + rloc];
#pragma unroll
            for (int j = 0; j < TC / 16; ++j) YRAW[(size_t)(rowbase + c * TC + j * 16 + cg_) * 512 + h * 64 + rq * 16 + rloc] = yk[j];
        }
        lds_barrier();
    }
    if (wave < 4) *(f32x4*)(p.out + O_PS + ((size_t)bh * 64 + rq * 16 + rloc) * 64 + cg_ * 4) = S;
    __syncthreads();
}

__device__ __forceinline__ void rwkv_sample_task(const Params& p, int s, int h) {
    unsigned char* ws = p.ws;
    const int lane = threadIdx.x & 63, rr = lane >> 4, cg_ = lane & 15;
    const int row = MP + s;
    const h16* ob = (const h16*)(ws + OFF_OPS16) + ((size_t)row * 8 + h) * 6 * 64;
    f32x4 r4, d4, k4, a4, b4;
    {
        const h16x4 hr = *(const h16x4*)(ob + cg_ * 4), hw = *(const h16x4*)(ob + 64 + cg_ * 4), hk = *(const h16x4*)(ob + 128 + cg_ * 4),
                    ha = *(const h16x4*)(ob + 256 + cg_ * 4), hb = *(const h16x4*)(ob + 320 + cg_ * 4);
#pragma unroll
        for (int j = 0; j < 4; ++j) { r4[j] = (float)hr[j]; d4[j] = __expf((float)hw[j]); k4[j] = (float)hk[j]; a4[j] = (float)ha[j]; b4[j] = (float)hb[j]; }
    }
    const float rk = ((const float*)(ws + OFF_RKS))[(size_t)row * 8 + h];
    const float* S0 = p.in[6] + ((size_t)s * 8 + h) * 4096;
    float* So = p.out + O_SS + ((size_t)s * 8 + h) * 4096;
    float ysel = 0.f;
#pragma unroll
    for (int g = 0; g < 16; ++g) {
        const int vrow = g * 4 + rr;
        const float vv = (float)ob[192 + vrow];
        f32x4 S = *(const f32x4*)(S0 + (size_t)vrow * 64 + cg_ * 4);
        float sa = S[0] * a4[0] + S[1] * a4[1] + S[2] * a4[2] + S[3] * a4[3];
        sa = row_sum16(sa);
        S = S * d4 + sa * b4 + vv * k4;
        float y = S[0] * r4[0] + S[1] * r4[1] + S[2] * r4[2] + S[3] * r4[3];
        y = row_sum16(y) + rk * vv;
        *(f32x4*)(So + (size_t)vrow * 64 + cg_ * 4) = S;
        ysel = (cg_ == g) ? y : ysel;
    }
    const int vr = cg_ * 4 + rr, col = h * 64 + vr;
    const float mu = wave_sum(ysel) * (1.f / 64.f);
    const float dlt = ysel - mu;
    const float rstd = rsqrtf(wave_sum(dlt * dlt) * (1.f / 64.f) + GN_EPS);
    const float gte = (float)((const h16*)((unsigned char*)p.out + OUTB_G16))[(size_t)row * 512 + col];
    ((h16*)((unsigned char*)p.out + OUTB_MIX16))[(size_t)row * D + 512 + col] = (h16)((dlt * rstd * p.in[24][col] + p.in[25][col]) * gte);
}

__device__ __forceinline__ void p3_scan(const Params& p, LAS unsigned char* lds) {
    for (int j = blockIdx.x; j < 256; j += gridDim.x) {
        const int xcd = j & 7, slot = j >> 3;
        rwkv_scan_prompt(p, lds, xcd * 8 + (slot >> 2), slot & 3);
    }
    const int wave = threadIdx.x >> 6;
    for (int i = blockIdx.x * 8 + wave; i < MS * 8; i += gridDim.x * 8) rwkv_sample_task(p, i >> 3, i & 7);
}

__device__ __forceinline__ void groupnorm_rows(const Params& p, int rbeg, int rend) {
    unsigned char* ws = p.ws;
    const int lane = threadIdx.x & 63, wave = threadIdx.x >> 6, c = lane * 8;
    const float* YRAW = (const float*)(ws + OFF_YRAW);
    const h16* G16 = (const h16*)((unsigned char*)p.out + OUTB_G16);
    h16* MIX = (h16*)((unsigned char*)p.out + OUTB_MIX16);
    const f32x4 w0 = *(const f32x4*)(p.in[24] + c), w1 = *(const f32x4*)(p.in[24] + c + 4), b0 = *(const f32x4*)(p.in[25] + c), b1 = *(const f32x4*)(p.in[25] + c + 4);
    const int stride = 8;
    for (int row0 = rbeg + wave; row0 < rend; row0 += 4 * stride) {
        f32x4 ya[4], yb[4]; h16x8 gg[4];
#pragma unroll
        for (int u = 0; u < 4; ++u) {
            const int r = row0 + u * stride, rc = r < rend ? r : row0;
            ya[u] = *(const f32x4*)(YRAW + (size_t)rc * 512 + c); yb[u] = *(const f32x4*)(YRAW + (size_t)rc * 512 + c + 4);
            gg[u] = *(const h16x8*)(G16 + (size_t)rc * 512 + c);
        }
#pragma unroll
        for (int u = 0; u < 4; ++u) {
            const int row = row0 + u * stride;
            f32x4 y0 = ya[u], y1 = yb[u];
            float s = y0[0] + y0[1] + y0[2] + y0[3] + y1[0] + y1[1] + y1[2] + y1[3];
            s = dpp_add<0xB1>(s); s = dpp_add<0x4E>(s); s += __shfl_xor(s, 4);
            const float mu = s * (1.f / 64.f);
            y0 -= mu; y1 -= mu;
            float q = y0[0] * y0[0] + y0[1] * y0[1] + y0[2] * y0[2] + y0[3] * y0[3] + y1[0] * y1[0] + y1[1] * y1[1] + y1[2] * y1[2] + y1[3] * y1[3];
            q = dpp_add<0xB1>(q); q = dpp_add<0x4E>(q); q += __shfl_xor(q, 4);
            const float rstd = rsqrtf(q * (1.f / 64.f) + GN_EPS);
            f32x4 o0, o1;
#pragma unroll
            for (int j = 0; j < 4; ++j) { o0[j] = (y0[j] * rstd * w0[j] + b0[j]) * (float)gg[u][j]; o1[j] = (y1[j] * rstd * w1[j] + b1[j]) * (float)gg[u][4 + j]; }
            if (row < rend) *(h16x8*)(MIX + (size_t)row * D + 512 + c) = pack8(o0, o1);
        }
    }
}

__device__ __forceinline__ void p7_final(const Params& p, bool prompt_done) {
    unsigned char* ws = p.ws;
    const int lane = threadIdx.x & 63, wave = threadIdx.x >> 6;
    const float* nw = p.in[30];
    const float* SS2 = (const float*)(ws + OFF_SS2);
    const h16* X2 = (const h16*)(ws + OFF_X1);
    f32x4 w[4];
#pragma unroll
    for (int j = 0; j < 4; ++j) w[j] = *(const f32x4*)(nw + lane * 4 + 256 * j);
    const int stride = gridDim.x * 8;
    if (!prompt_done)
    for (int row = blockIdx.x * 8 + wave; row < MP; row += 4 * stride) {
        h16x4 v[4][4]; float rstd[4];
#pragma unroll
        for (int u = 0; u < 4; ++u) {
            const int r = row + u * stride, rc = r < MP ? r : row;
            rstd[u] = rsqrtf(SS2[rc] * (1.f / D) + EPS);
#pragma unroll
            for (int j = 0; j < 4; ++j) v[u][j] = *(const h16x4*)(X2 + (size_t)rc * D + lane * 4 + 256 * j);
        }
#pragma unroll
        for (int u = 0; u < 4; ++u) {
            const int r = row + u * stride;
            if (r < MP) {
#pragma unroll
                for (int j = 0; j < 4; ++j) {
                    f32x4 o;
#pragma unroll
                    for (int e = 0; e < 4; ++e) o[e] = (float)v[u][j][e] * rstd[u] * w[j][e];
                    *(f32x4*)(p.out + O_YP + (size_t)r * D + lane * 4 + 256 * j) = o;
                }
            }
        }
    }
    for (int s = blockIdx.x * 8 + wave; s < MS; s += stride) {
        float* xr = p.out + O_YS + (size_t)s * D;
        const float rstd = rsqrtf(SS2[MP + s] * (1.f / D) + EPS);
#pragma unroll
        for (int j = 0; j < 4; ++j) { const f32x4 v = *(const f32x4*)(xr + lane * 4 + 256 * j); *(f32x4*)(xr + lane * 4 + 256 * j) = v * rstd * w[j]; }
    }
}

__global__ void __launch_bounds__(512, 2) hymba_fwd(Params p) {
    extern __shared__ __attribute__((aligned(16))) unsigned char shm[];
    LAS unsigned char* lds = (LAS unsigned char*)shm;
    cg::grid_group grid = cg::this_grid();
    unsigned char* ws = p.ws;
    const int G = gridDim.x, c = blockIdx.x;

    XB xb; xb.bar = (unsigned*)(ws + OFF_BAR); xb.x = xb_xcc_id();
    if (c == 0) for (int i = threadIdx.x; i < 2176; i += 512) xb.bar[1024 + i] = 0u;
    if (threadIdx.x == 0) xb.bar[3200 + c] = xb.x;
    p0_prep(p, lds);
    grid.sync();
    {
        LAS unsigned* hist = (LAS unsigned*)lds;
        if (threadIdx.x < 16) hist[threadIdx.x] = 0u;
        __syncthreads();
        for (int i = threadIdx.x; i < G; i += 512) atomicAdd((unsigned*)(hist + (xb_ld(&xb.bar[3200 + i]) & 15u)), 1u);
        __syncthreads();
        unsigned cnt = 0u;
#pragma unroll
        for (unsigned j = 0; j < 16; ++j) cnt += (hist[j] > 0u) ? 1u : 0u;
        const unsigned mine = hist[xb.x];
        xb.nloc = mine > 0u ? mine : 1u; xb.nx = cnt > 0u ? cnt : 1u;
        __syncthreads();
    }
    {
        pg8::Gemm g{(const h16*)(ws + OFF_XN16), (const h16*)(ws + OFF_WT_IN), MPAD, NPROJ, D};
        pg8::StaticOrder S; S.init(MPAD, NPROJ, G, c);
        Epi<0> E{(h16*)(ws + OFF_PROJ16), NPROJ, nullptr, 0, nullptr, 0, nullptr, nullptr};
        pg8::gemm_phase(lds, g, S, E);
        skinny<SK_GATES>(p, (const h16*)(ws + OFF_XN16), D, 0, MALL / 16, (const h16*)(ws + OFF_WT_G), D, 1);
    }
    xcd_barrier(xb);
    p2_mixprep(p, lds);
    xcd_barrier(xb);
    p3_scan(p, lds);
    xcd_barrier(xb);
    {
        const h16* MIX = (const h16*)((unsigned char*)p.out + OUTB_MIX16);
        pg8::Gemm g{MIX, (const h16*)(ws + OFF_WT_OUT), MP, D, D};
        pg8::StaticOrder S; S.init(MP, D, G, c);
        { pg8::Unit u0; for (int i = 0; S.next(i, u0); ++i) groupnorm_rows(p, u0.pm * 256, u0.pm * 256 + 256); }
        asm volatile("s_waitcnt vmcnt(0)" ::: "memory");
        __syncthreads();
        Epi<1> E{(h16*)(ws + OFF_X116), D, nullptr, 0, p.in[0], D, (float*)(ws + OFF_SS1), nullptr};
        pg8::gemm_phase(lds, g, S, E);
        skinny<SK_OUT>(p, MIX, D, MP, MS / 16, (const h16*)(ws + OFF_WT_OUT), D, D / 16);
    }
    xcd_barrier(xb);
    {
        pg8::Gemm g{(const h16*)(ws + OFF_X116), (const h16*)(ws + OFF_WT_UP), MP, DFF, D};
        pg8::StaticOrder S; S.init(MP, DFF, G, c);
        Epi<2> E{(h16*)(ws + OFF_HID16), DFF, nullptr, 0, nullptr, 0, (float*)(ws + OFF_SS1), nullptr};
        pg8::gemm_phase(lds, g, S, E);
        skinny<SK_UP>(p, (const h16*)(ws + OFF_X116), D, MP, MS / 16, (const h16*)(ws + OFF_WT_UP), D, DFF / 16);
    }
    xcd_barrier(xb);
    {
        pg8::Gemm g{(const h16*)(ws + OFF_HID16), (const h16*)(ws + OFF_WT_DN), MP, D, DFF};
        pg8::StaticOrder S; S.init(MP, D, G, c);
        if (G == 256) {
            EpiFinal E{p.out + O_YP, (const h16*)(ws + OFF_X116), (float*)(ws + OFF_SS2), (unsigned*)(ws + OFF_CNT), p.in[30]};
            pg8::gemm_phase(lds, g, S, E);
        } else {
            Epi<3> E{(h16*)(ws + OFF_X1), D, nullptr, 0, nullptr, D, (float*)(ws + OFF_SS2), (const h16*)(ws + OFF_X116)};
            pg8::gemm_phase(lds, g, S, E);
        }
        skinny_down_splitk(p, lds);
    }
    xcd_barrier(xb);
    p7_final(p, G == 256);
}

extern "C" void kernel_launch(void* const* d_in, const int* in_sizes, int n_in, void* d_out, int out_size, void* d_ws, size_t ws_size, hipStream_t stream) {
    static int grid_blocks = 0;
    if (grid_blocks == 0) {
        int dev = 0, cus = 0, per_cu = 0;
        (void)hipGetDevice(&dev);
        (void)hipDeviceGetAttribute(&cus, hipDeviceAttributeMultiprocessorCount, dev);
        if (hipFuncSetAttribute((const void*)hymba_fwd, hipFuncAttributeMaxDynamicSharedMemorySize, LDS_BYTES) != hipSuccess) fprintf(stderr, "hipFuncSetAttribute failed\n");
        if (hipOccupancyMaxActiveBlocksPerMultiprocessor(&per_cu, (const void*)hymba_fwd, 512, LDS_BYTES) != hipSuccess || per_cu < 1) { fprintf(stderr, "occupancy query: %d\n", per_cu); per_cu = 1; }
        (void)hipGetLastError();
        grid_blocks = cus;
        if (ws_size < 268435456ull) fprintf(stderr, "workspace too small: %zu\n", ws_size);
    }
    Params p{};
    for (int i = 0; i < 31; ++i) p.in[i] = (const float*)d_in[i];
    p.out = (float*)d_out; p.ws = (unsigned char*)d_ws;
    void* args[] = {&p};
    hipError_t e = hipLaunchCooperativeKernel((const void*)hymba_fwd, dim3(grid_blocks), dim3(512), args, LDS_BYTES, stream);
    if (e != hipSuccess) fprintf(stderr, "cooperative launch failed: %s (grid %d)\n", hipGetErrorString(e), grid_blocks);
}
```

```cpp
#include <hip/hip_runtime.h>
#include <hip/hip_cooperative_groups.h>
#include <cstdio>
namespace cg = cooperative_groups;

#define LAS __attribute__((address_space(3)))
typedef _Float16 h16;
typedef _Float16 h16x8 __attribute__((ext_vector_type(8)));
typedef _Float16 h16x4 __attribute__((ext_vector_type(4)));
typedef float f32x4 __attribute__((ext_vector_type(4)));
typedef unsigned u32x4 __attribute__((ext_vector_type(4)));

constexpr int D = 1024, MP = 16384, MS = 128, MALL = 16512, MPAD = 16640, SEQ = 2048;
constexpr int NPROJ = 3840;
constexpr int RWW = 1792, DFF = 4096;
constexpr float EPS = 1e-6f, GN_EPS = 64e-5f;
constexpr int LDS_BYTES = 131072;

constexpr size_t OFF_WT_IN = 0;
constexpr size_t OFF_WT_G = OFF_WT_IN + (size_t)NPROJ * D * 2;
constexpr size_t OFF_WT_OUT = OFF_WT_G + 16 * D * 2;
constexpr size_t OFF_WT_UP = OFF_WT_OUT + (size_t)D * D * 2;
constexpr size_t OFF_WT_DN = OFF_WT_UP + (size_t)DFF * D * 2;
constexpr size_t OFF_LW = OFF_WT_DN + (size_t)DFF * D * 2;
constexpr size_t OFF_LA = OFF_LW + 512 * 64 * 2;
constexpr size_t OFF_LG = OFF_LA + 512 * 64 * 2;
constexpr size_t OFF_GATES = OFF_LG + 512 * 128 * 2;
constexpr size_t OFF_SS1 = OFF_GATES + (size_t)MPAD * 16 * 4;
constexpr size_t OFF_SS2 = OFF_SS1 + (size_t)MPAD * 4;
constexpr size_t OFF_RKS = OFF_SS2 + (size_t)MPAD * 4;
constexpr size_t OFF_CNT = OFF_RKS + (size_t)MPAD * 8 * 4;
constexpr size_t OFF_BAR = OFF_CNT + 256;
constexpr size_t OFF_DYN = OFF_BAR + 16384;
constexpr size_t OFF_XN16 = OFF_DYN;
constexpr size_t OFF_OPS16 = OFF_DYN;
constexpr size_t OFF_PROJ16 = 268435456ull - (size_t)MPAD * NPROJ * 2;
constexpr size_t OFF_YRAW = OFF_PROJ16;
constexpr size_t OFF_X1 = OFF_DYN;
constexpr size_t OFF_X116 = OFF_X1 + (size_t)MPAD * D * 4;
constexpr size_t OFF_HID16 = OFF_X116 + (size_t)MPAD * D * 2;
static_assert(OFF_DYN % 256 == 0 && OFF_PROJ16 % 256 == 0, "align");
static_assert(OFF_OPS16 + (size_t)MALL * 8 * 6 * 64 * 2 <= OFF_PROJ16, "ops overlap");
static_assert(OFF_HID16 + (size_t)MPAD * DFF * 2 <= 268435456ull, "ws overflow");
constexpr size_t OUTB_MIX16 = 0, OUTB_G16 = (size_t)MPAD * D * 2;
static_assert(OUTB_G16 + (size_t)MALL * 512 * 2 <= (size_t)MP * D * 4, "out scratch overflow");
constexpr size_t O_YP = 0, O_YS = 16777216, O_PC = 16908288, O_PN = 17170432, O_PM = 17174528, O_PCONV = 17174592, O_PS = 17199168,
                 O_PSH = 17461312, O_SC = 17475648, O_SN = 21669952, O_SM = 21735488, O_SCONV = 21736512, O_SS = 22129728, O_SSH = 26324032;

struct Params { const float* in[31]; float* out; unsigned char* ws; };

__device__ __forceinline__ f32x4 mfma16(h16x8 a, h16x8 b, f32x4 c) { return __builtin_amdgcn_mfma_f32_16x16x32_f16(a, b, c, 0, 0, 0); }
__device__ __forceinline__ float wave_sum(float v) {
#pragma unroll
    for (int o = 1; o < 64; o <<= 1) v += __shfl_xor(v, o);
    return v;
}
__device__ __forceinline__ float wave_max(float v) {
#pragma unroll
    for (int o = 1; o < 64; o <<= 1) v = fmaxf(v, __shfl_xor(v, o));
    return v;
}
__device__ __forceinline__ void lds_barrier() { asm volatile("s_waitcnt lgkmcnt(0)\n\ts_barrier" ::: "memory"); }
#define XB_XCNT(j) (64 * (j))
#define XB_XSUB(j) (1024 + 64 * (j))
#define XB_XGEN(j) (2048 + 64 * (j))
#define XB_TOP 3072
#define XB_TOPGEN 3136
__device__ __forceinline__ unsigned xb_ld(unsigned* p) { return __hip_atomic_load(p, __ATOMIC_RELAXED, __HIP_MEMORY_SCOPE_AGENT); }
__device__ __forceinline__ unsigned xb_add(unsigned* p, unsigned v) { return __hip_atomic_fetch_add(p, v, __ATOMIC_RELAXED, __HIP_MEMORY_SCOPE_AGENT); }
__device__ __forceinline__ unsigned xb_xcc_id() { return (unsigned)__builtin_amdgcn_s_getreg((3 << 11) | 20) & 0xFu; }
struct XB { unsigned* bar; unsigned x, nloc, nx; };
__device__ __forceinline__ void xcd_barrier(const XB& b) {
    __syncthreads();
    if (threadIdx.x == 0) {
        unsigned* bar = b.bar;
        __builtin_amdgcn_fence(__ATOMIC_RELEASE, "agent");
        asm volatile("s_waitcnt vmcnt(0)" ::: "memory");
        const unsigned old = xb_add(&bar[XB_XSUB(b.x)], 1u);
        const unsigned gen = old / b.nloc;
        if (old + 1u == (gen + 1u) * b.nloc) {
            const unsigned og = xb_add(&bar[XB_TOP], 1u);
            const unsigned target = (og / b.nx + 1u) * b.nx;
            if (og + 1u != target) while (xb_ld(&bar[XB_TOP]) < target) __builtin_amdgcn_s_sleep(1);
            xb_add(&bar[XB_XGEN(b.x)], 1u);
        } else {
            while (xb_ld(&bar[XB_XGEN(b.x)]) == gen) __builtin_amdgcn_s_sleep(1);
        }
        __builtin_amdgcn_fence(__ATOMIC_ACQUIRE, "agent");
        asm volatile("s_waitcnt vmcnt(0)" ::: "memory");
    }
    __syncthreads();
}
__device__ __forceinline__ float sigm(float x) { return __builtin_amdgcn_rcpf(1.f + __expf(-x)); }
template <int CTRL> __device__ __forceinline__ float dpp_add(float x) {
    return x + __builtin_bit_cast(float, __builtin_amdgcn_update_dpp(0, __builtin_bit_cast(int, x), CTRL, 0xF, 0xF, true));
}
__device__ __forceinline__ float row_sum16(float x) { x = dpp_add<0xB1>(x); x = dpp_add<0x4E>(x); x = dpp_add<0x124>(x); x = dpp_add<0x128>(x); return x; }

namespace pg8 {
constexpr int BM = 256, BK = 64, HALF = 128, HTB = HALF * BK * 2, NXCD = 8, WGM = 8;
__device__ __forceinline__ int lds_byte(int r, int c) { const int st = (r >> 4) * 2 + (c >> 5), rr = r & 15, cc = c & 31, ob = rr * 64 + cc * 2; return st * 1024 + (ob ^ (((ob >> 9) & 1) << 5)); }
__device__ __forceinline__ void stage_rc(int b, int& R, int& C) { const int st = b / 1024, sb = b % 1024, swz = sb ^ (((sb >> 9) & 1) << 5); R = (st >> 1) * 16 + swz / 64; C = (st & 1) * 32 + (swz % 64) / 2; }
__device__ __forceinline__ int perm32(int rho) { const int n = rho >> 4, i = rho & 15; return 8 * (i >> 2) + 4 * n + (i & 3); }
struct Unit { int pm, pn; };
struct Gemm { const h16* A; const h16* Bt; int M, N, K; };
struct StaticOrder {
    int nM, nN, nwg, G, c;
    __device__ void init(int M, int N, int G_, int c_) { nM = M / BM; nN = N / BM; nwg = nM * nN; G = G_; c = c_; }
    __device__ bool next(int i, Unit& u) const {
        const long L = (long)i * G + c; if (L >= nwg) return false;
        int wgid = (int)L; { const int q = nwg / NXCD, r = nwg % NXCD, xcd = wgid % NXCD, off = wgid / NXCD; wgid = (xcd < r ? xcd * (q + 1) : r * (q + 1) + (xcd - r) * q) + off; }
        const int nig = WGM * nN, gid = wgid / nig, fm = gid * WGM, gsz = (nM - fm) < WGM ? (nM - fm) : WGM;
        u.pm = fm + ((wgid % nig) % gsz); u.pn = (wgid % nig) / gsz; return true;
    }
};

template <class Epi>
__device__ __forceinline__ void gemm_phase(LAS unsigned char* lds, const Gemm g, const StaticOrder& S, const Epi& E) {
    int tid = threadIdx.x;
    asm volatile("" : "+v"(tid));
    const int wid = __builtin_amdgcn_readfirstlane(tid >> 6), lane = tid & 63, wr = wid >> 2, wc = wid & 3, fr = lane & 15, fq = lane >> 4;
    const int K = g.K, nt = K / BK;
    unsigned voffA[2], voffB[2];
#pragma unroll
    for (int i = 0; i < 2; ++i) { int R, C; stage_rc(tid * 16 + i * 8192, R, C); const int Rb = (R & ~31) + perm32(R & 31);
        voffA[i] = (unsigned)(R * K + C) * 2u; voffB[i] = (unsigned)(Rb * K + C) * 2u; }
    const size_t kstep = (size_t)(BK * 2);
    const size_t hstep = (size_t)HALF * K * 2;
    const size_t tstep = 2 * hstep;
    const unsigned ldsw = (unsigned)wid * 1024u;
    const int aoff = lds_byte(wr * 64 + fr, fq * 8), boff = lds_byte(wc * 32 + fr, fq * 8);
#define PG8_SA(b, h) (((b) * 2 + (h)) * HTB)
#define PG8_SB(b, h) ((4 + (b) * 2 + (h)) * HTB)
#define PG8_STAGE(bufoff, gbase, voff) do { _Pragma("unroll") for (int _i = 0; _i < 2; ++_i) \
        __builtin_amdgcn_global_load_lds((const unsigned*)((const char*)(gbase) + (voff)[_i]), (LAS unsigned*)(lds + (bufoff) + ldsw + _i * 8192), 16, 0, 0); } while (0)
#define PG8_LDA(dst, b, h) do { _Pragma("unroll") for (int m = 0; m < 4; ++m) _Pragma("unroll") for (int k = 0; k < 2; ++k) dst[m][k] = *(const LAS h16x8*)(lds + PG8_SA(b, h) + aoff + m * 2048 + k * 1024); } while (0)
#define PG8_LDB(dst, b, h) do { _Pragma("unroll") for (int n = 0; n < 2; ++n) _Pragma("unroll") for (int k = 0; k < 2; ++k) dst[n][k] = *(const LAS h16x8*)(lds + PG8_SB(b, h) + boff + n * 2048 + k * 1024); } while (0)
#define PG8_MMA(ai, bj, At, Bt) do { __builtin_amdgcn_s_setprio(1); _Pragma("unroll") for (int m = 0; m < 4; ++m) _Pragma("unroll") for (int n = 0; n < 2; ++n) _Pragma("unroll") for (int k = 0; k < 2; ++k) \
        acc[ai][bj][m][n] = __builtin_amdgcn_mfma_f32_16x16x32_f16(Bt[n][k], At[m][k], acc[ai][bj][m][n], 0, 0, 0); __builtin_amdgcn_s_setprio(0); } while (0)
#define PG8_WAIT_V(n) asm volatile("s_waitcnt vmcnt(" #n ")" ::: "memory")
#define PG8_WAIT_L(n) asm volatile("s_waitcnt lgkmcnt(" #n ")" ::: "memory")
#define PG8_BAR __builtin_amdgcn_s_barrier()
#define PG8_SCHED __builtin_amdgcn_sched_barrier(0)
    Unit cur, nxt; int ui = 0;
    if (!S.next(0, cur)) return;
    f32x4 acc[2][2][4][2];
#pragma unroll
    for (int a = 0; a < 2; ++a)
#pragma unroll
        for (int b = 0; b < 2; ++b)
#pragma unroll
            for (int m = 0; m < 4; ++m)
#pragma unroll
                for (int n = 0; n < 2; ++n) acc[a][b][m][n] = (f32x4){0.f, 0.f, 0.f, 0.f};
    h16x8 At[4][2], B0[2][2], B1[2][2];
    const char* cA = (const char*)g.A + (size_t)cur.pm * tstep; const char* cB = (const char*)g.Bt + (size_t)cur.pn * tstep;
    PG8_STAGE(PG8_SB(0, 0), cB, voffB); PG8_STAGE(PG8_SA(0, 0), cA, voffA); PG8_STAGE(PG8_SB(0, 1), cB + hstep, voffB); PG8_STAGE(PG8_SA(0, 1), cA + hstep, voffA);
    if (wr == 1) PG8_BAR;
    PG8_WAIT_V(4); PG8_BAR;
    PG8_STAGE(PG8_SB(1, 0), cB + kstep, voffB); PG8_STAGE(PG8_SA(1, 0), cA + kstep, voffA); PG8_STAGE(PG8_SB(1, 1), cB + hstep + kstep, voffB);
    PG8_WAIT_V(6); PG8_BAR;
    for (;;) {
        const bool has_next = S.next(ui + 1, nxt);
        const char* nA = has_next ? (const char*)g.A + (size_t)nxt.pm * tstep : cA; const char* nB = has_next ? (const char*)g.Bt + (size_t)nxt.pn * tstep : cB;
        for (int t = 0; t < nt; t += 2) {
            const bool last = (t == nt - 2);
            const char* a1 = cA + (size_t)(t + 1) * kstep;
            const char* a2 = last ? nA : cA + (size_t)(t + 2) * kstep; const char* b2 = last ? nB : cB + (size_t)(t + 2) * kstep;
            const char* a3 = a2 + kstep; const char* b3 = b2 + kstep;
            PG8_LDB(B0, 0, 0); PG8_SCHED; PG8_LDA(At, 0, 0); PG8_STAGE(PG8_SA(1, 1), a1 + hstep, voffA);
            PG8_WAIT_L(8); PG8_BAR; PG8_WAIT_L(0); PG8_MMA(0, 0, At, B0); PG8_BAR; PG8_SCHED;
            PG8_LDB(B1, 0, 1); PG8_STAGE(PG8_SB(0, 0), b2, voffB);
            PG8_BAR; PG8_WAIT_L(0); PG8_MMA(0, 1, At, B1); PG8_BAR;
            PG8_LDA(At, 0, 1); PG8_STAGE(PG8_SA(0, 0), a2, voffA);
            PG8_BAR; PG8_WAIT_L(0); PG8_MMA(1, 0, At, B0); PG8_BAR; PG8_SCHED;
            PG8_STAGE(PG8_SB(0, 1), b2 + hstep, voffB);
            PG8_WAIT_V(6); PG8_BAR; PG8_MMA(1, 1, At, B1); PG8_BAR;
            PG8_LDB(B0, 1, 0); PG8_SCHED; PG8_LDA(At, 1, 0); PG8_STAGE(PG8_SA(0, 1), a2 + hstep, voffA);
            PG8_WAIT_L(8); PG8_BAR; PG8_WAIT_L(0); PG8_MMA(0, 0, At, B0); PG8_BAR; PG8_SCHED;
            PG8_LDB(B1, 1, 1); PG8_STAGE(PG8_SB(1, 0), b3, voffB);
            PG8_BAR; PG8_WAIT_L(0); PG8_MMA(0, 1, At, B1); PG8_BAR;
            PG8_LDA(At, 1, 1); PG8_STAGE(PG8_SA(1, 0), a3, voffA);
            PG8_BAR; PG8_WAIT_L(0); PG8_MMA(1, 0, At, B0); PG8_BAR; PG8_SCHED;
            PG8_STAGE(PG8_SB(1, 1), b3 + hstep, voffB);
            PG8_WAIT_V(6); PG8_BAR; PG8_MMA(1, 1, At, B1); PG8_BAR;
        }
        if constexpr (!Epi::AFTER_DRAIN) E(acc, cur, wr, wc, fr, fq);
        if (!has_next) break;
#pragma unroll
        for (int a = 0; a < 2; ++a)
#pragma unroll
            for (int b = 0; b < 2; ++b)
#pragma unroll
                for (int m = 0; m < 4; ++m)
#pragma unroll
                    for (int n = 0; n < 2; ++n) acc[a][b][m][n] = (f32x4){0.f, 0.f, 0.f, 0.f};
        cur = nxt; cA = nA; cB = nB; ++ui;
    }
    PG8_WAIT_V(0);
    if (wr == 0) PG8_BAR;
    PG8_BAR;
    if constexpr (Epi::AFTER_DRAIN) E(acc, cur, wr, wc, fr, fq);
#undef PG8_SA
#undef PG8_SB
#undef PG8_STAGE
#undef PG8_LDA
#undef PG8_LDB
#undef PG8_MMA
#undef PG8_WAIT_V
#undef PG8_WAIT_L
#undef PG8_BAR
#undef PG8_SCHED
}
}

__device__ __forceinline__ h16x8 pack8(f32x4 a, f32x4 b) {
    h16x8 o; o[0] = (h16)a[0]; o[1] = (h16)a[1]; o[2] = (h16)a[2]; o[3] = (h16)a[3]; o[4] = (h16)b[0]; o[5] = (h16)b[1]; o[6] = (h16)b[2]; o[7] = (h16)b[3]; return o;
}
__device__ __forceinline__ h16x4 pack4(f32x4 a) { h16x4 o; o[0] = (h16)a[0]; o[1] = (h16)a[1]; o[2] = (h16)a[2]; o[3] = (h16)a[3]; return o; }

template <int MODE> struct Epi {
    static constexpr bool AFTER_DRAIN = false;
    h16* o16; int ld16; float* o32; int ld32; const float* res; int ldres; float* rowss; const h16* res16;
    __device__ __forceinline__ void operator()(const f32x4 (&acc)[2][2][4][2], const pg8::Unit& u, int wr, int wc, int fr, int fq) const {
        const int row0 = u.pm * 256 + wr * 64 + fr, col0 = u.pn * 256 + wc * 32 + 8 * fq;
#pragma unroll
        for (int ai = 0; ai < 2; ++ai)
#pragma unroll
            for (int m = 0; m < 4; ++m) {
                const int row = row0 + ai * 128 + m * 16;
                float ss = 0.f, rstd = 1.f;
                if (MODE == 2) rstd = rsqrtf(rowss[row] * (1.f / 1024.f) + EPS);
#pragma unroll
                for (int bj = 0; bj < 2; ++bj) {
                    const int c = col0 + bj * 128;
                    f32x4 v0 = acc[ai][bj][m][0], v1 = acc[ai][bj][m][1];
                    if (MODE == 1) {
                        const float* rp = res + (size_t)row * ldres + c;
                        v0 += *(const f32x4*)rp; v1 += *(const f32x4*)(rp + 4);
                    }
                    if (MODE == 3) {
                        const h16x8 r8 = *(const h16x8*)(res16 + (size_t)row * ldres + c);
#pragma unroll
                        for (int j = 0; j < 4; ++j) { v0[j] += (float)r8[j]; v1[j] += (float)r8[4 + j]; }
                    }
                    if (MODE == 1 || MODE == 3) {
                        ss += v0[0] * v0[0] + v0[1] * v0[1] + v0[2] * v0[2] + v0[3] * v0[3] + v1[0] * v1[0] + v1[1] * v1[1] + v1[2] * v1[2] + v1[3] * v1[3];
                    }
                    if (MODE == 2) {
#pragma unroll
                        for (int j = 0; j < 4; ++j) { float a = fmaxf(v0[j] * rstd, 0.f), b = fmaxf(v1[j] * rstd, 0.f); v0[j] = a * a; v1[j] = b * b; }
                    }
                    *(h16x8*)(o16 + (size_t)row * ld16 + c) = pack8(v0, v1);
                }
                if (MODE == 1 || MODE == 3) {
                    ss += __shfl_xor(ss, 16); ss += __shfl_xor(ss, 32);
                    if (fq == 0) atomicAdd(rowss + row, ss);
                }
            }
    }
};

struct EpiFinal {
    static constexpr bool AFTER_DRAIN = true;
    float* out; const h16* res16; float* rowss; unsigned* cnt; const float* nw;
    __device__ __forceinline__ void operator()(f32x4 (&acc)[2][2][4][2], const pg8::Unit& u, int wr, int wc, int fr, int fq) const {
        const int row0 = u.pm * 256 + wr * 64 + fr, col0 = u.pn * 256 + wc * 32 + 8 * fq;
#pragma unroll
        for (int ai = 0; ai < 2; ++ai)
#pragma unroll
            for (int m = 0; m < 4; ++m) {
                const int row = row0 + ai * 128 + m * 16;
                float ss = 0.f;
#pragma unroll
                for (int bj = 0; bj < 2; ++bj) {
                    const int c = col0 + bj * 128;
                    const h16x8 r8 = *(const h16x8*)(res16 + (size_t)row * D + c);
                    f32x4 v0 = acc[ai][bj][m][0], v1 = acc[ai][bj][m][1];
#pragma unroll
                    for (int j = 0; j < 4; ++j) { v0[j] += (float)r8[j]; v1[j] += (float)r8[4 + j]; }
                    acc[ai][bj][m][0] = v0; acc[ai][bj][m][1] = v1;
                    ss += v0[0] * v0[0] + v0[1] * v0[1] + v0[2] * v0[2] + v0[3] * v0[3] + v1[0] * v1[0] + v1[1] * v1[1] + v1[2] * v1[2] + v1[3] * v1[3];
                }
                ss += __shfl_xor(ss, 16); ss += __shfl_xor(ss, 32);
                if (fq == 0) atomicAdd(rowss + row, ss);
            }
        asm volatile("s_waitcnt vmcnt(0)" ::: "memory");
        __syncthreads();
        if (threadIdx.x == 0) {
            __hip_atomic_fetch_add(cnt + u.pm, 1u, __ATOMIC_RELAXED, __HIP_MEMORY_SCOPE_AGENT);
            unsigned spins = 0;
            while (__hip_atomic_load(cnt + u.pm, __ATOMIC_RELAXED, __HIP_MEMORY_SCOPE_AGENT) < 4u && ++spins < (1u << 20)) __builtin_amdgcn_s_sleep(1);
        }
        __syncthreads();
#pragma unroll
        for (int ai = 0; ai < 2; ++ai)
#pragma unroll
            for (int m = 0; m < 4; ++m) {
                const int row = row0 + ai * 128 + m * 16;
                const float rstd = rsqrtf(__hip_atomic_load(rowss + row, __ATOMIC_RELAXED, __HIP_MEMORY_SCOPE_AGENT) * (1.f / 1024.f) + EPS);
#pragma unroll
                for (int bj = 0; bj < 2; ++bj) {
                    const int c = col0 + bj * 128;
                    const f32x4 w0 = *(const f32x4*)(nw + c), w1 = *(const f32x4*)(nw + c + 4);
                    float* op = out + (size_t)row * D + c;
                    *(f32x4*)op = acc[ai][bj][m][0] * rstd * w0; *(f32x4*)(op + 4) = acc[ai][bj][m][1] * rstd * w1;
                }
            }
    }
};

enum { SK_GATES = 0, SK_OUT = 1, SK_UP = 2, SK_DOWN = 3 };
template <int MODE>
__device__ __forceinline__ void skinny(const Params& p, const h16* A, int lda, int row0, int nrt, const h16* Bt, int K, int nct) {
    const int lane = threadIdx.x & 63, wave = threadIdx.x >> 6, fr = lane & 15, fq = lane >> 4;
    const int gw = blockIdx.x * 8 + wave, ngw = gridDim.x * 8;
    unsigned char* ws = p.ws;
    for (int task = gw; task < nrt * nct; task += ngw) {
        const int rt = task % nrt, ct = task / nrt;
        const h16* ap = A + (size_t)(row0 + rt * 16 + fr) * lda + fq * 8;
        const h16* bp = Bt + (size_t)(ct * 16 + fr) * K + fq * 8;
        f32x4 acc = {0.f, 0.f, 0.f, 0.f};
#pragma unroll 8
        for (int k = 0; k < K; k += 32) { const h16x8 a = *(const h16x8*)(ap + k); const h16x8 b = *(const h16x8*)(bp + k); acc = mfma16(b, a, acc); }
        const int row = row0 + rt * 16 + fr, col = ct * 16 + fq * 4;
        if (MODE == SK_GATES) {
            const float* bi = p.in[12]; const float* bf = p.in[13];
            f32x4 o;
#pragma unroll
            for (int r = 0; r < 4; ++r) { const int cc = col + r; o[r] = acc[r] + (cc < 8 ? bi[cc] : bf[cc - 8]); }
            *(f32x4*)((float*)(ws + OFF_GATES) + (size_t)row * 16 + col) = o;
        } else if (MODE == SK_OUT) {
            const int s = row - MP;
            f32x4 v = acc + *(const f32x4*)(p.in[1] + (size_t)s * D + col);
            *(f32x4*)((float*)(ws + OFF_X1) + (size_t)row * D + col) = v;
            *(h16x4*)((h16*)(ws + OFF_X116) + (size_t)row * D + col) = pack4(v);
            float ss = v[0] * v[0] + v[1] * v[1] + v[2] * v[2] + v[3] * v[3];
            ss += __shfl_xor(ss, 16); ss += __shfl_xor(ss, 32);
            if (fq == 0) atomicAdd((float*)(ws + OFF_SS1) + row, ss);
        } else if (MODE == SK_UP) {
            const float rstd = rsqrtf(((const float*)(ws + OFF_SS1))[row] * (1.f / 1024.f) + EPS);
            f32x4 v;
#pragma unroll
            for (int r = 0; r < 4; ++r) { const float a = fmaxf(acc[r] * rstd, 0.f); v[r] = a * a; }
            *(h16x4*)((h16*)(ws + OFF_HID16) + (size_t)row * DFF + col) = pack4(v);
        } else {
            const int s = row - MP;
            f32x4 v = acc + *(const f32x4*)((const float*)(ws + OFF_X1) + (size_t)row * D + col);
            *(f32x4*)(p.out + O_YS + (size_t)s * D + col) = v;
            float ss = v[0] * v[0] + v[1] * v[1] + v[2] * v[2] + v[3] * v[3];
            ss += __shfl_xor(ss, 16); ss += __shfl_xor(ss, 32);
            if (fq == 0) atomicAdd((float*)(ws + OFF_SS2) + row, ss);
        }
    }
}

__device__ __forceinline__ void skinny_down_splitk(const Params& p, LAS unsigned char* lds) {
    unsigned char* ws = p.ws;
    LAS float* RED = (LAS float*)lds;
    const int lane = threadIdx.x & 63, wave = threadIdx.x >> 6, fr = lane & 15, fq = lane >> 4, grp = wave >> 2, ksp = wave & 3;
    const h16* A = (const h16*)(ws + OFF_HID16); const h16* Bt = (const h16*)(ws + OFF_WT_DN);
    constexpr int NRT = MS / 16, NCT = D / 16;
    for (int t0 = blockIdx.x * 2; t0 < NRT * NCT; t0 += gridDim.x * 2) {
        const int task = t0 + grp;
        const bool act = task < NRT * NCT;
        const int rt = act ? task % NRT : 0, ct = act ? task / NRT : 0;
        const h16* ap = A + (size_t)(MP + rt * 16 + fr) * DFF + ksp * 1024 + fq * 8;
        const h16* bp = Bt + (size_t)(ct * 16 + fr) * DFF + ksp * 1024 + fq * 8;
        f32x4 acc = {0.f, 0.f, 0.f, 0.f};
#pragma unroll 8
        for (int k = 0; k < 1024; k += 32) { const h16x8 a = *(const h16x8*)(ap + k); const h16x8 b = *(const h16x8*)(bp + k); acc = mfma16(b, a, acc); }
        *(LAS f32x4*)(RED + ((grp * 4 + ksp) * 64 + lane) * 4) = acc;
        __syncthreads();
        if (ksp == 0 && act) {
#pragma unroll
            for (int q = 1; q < 4; ++q) acc += *(const LAS f32x4*)(RED + ((grp * 4 + q) * 64 + lane) * 4);
            const int row = MP + rt * 16 + fr, col = ct * 16 + fq * 4, sidx = row - MP;
            f32x4 v = acc + *(const f32x4*)((const float*)(ws + OFF_X1) + (size_t)row * D + col);
            *(f32x4*)(p.out + O_YS + (size_t)sidx * D + col) = v;
            float ss = v[0] * v[0] + v[1] * v[1] + v[2] * v[2] + v[3] * v[3];
            ss += __shfl_xor(ss, 16); ss += __shfl_xor(ss, 32);
            if (fq == 0) atomicAdd((float*)(ws + OFF_SS2) + row, ss);
        }
        __syncthreads();
    }
}

__device__ __forceinline__ void tr_tile(const float* W, int K, int N, int kt, int nt, LAS float* tile, const float* kscale, h16* dst, int mode, h16* dstG) {
    const int tid = threadIdx.x, k0 = kt * 64, n0 = nt * 64;
    {
        const int kr = tid >> 4, nc = (tid & 15) * 4;
#pragma unroll
        for (int i = 0; i < 2; ++i) {
            const int k = kr + 32 * i;
            f32x4 v = {0.f, 0.f, 0.f, 0.f};
            if (n0 + nc < N) v = *(const f32x4*)(W + (size_t)(k0 + k) * N + n0 + nc);
            const float s = kscale ? kscale[k0 + k] : 1.f;
            tile[k * 65 + nc] = v[0] * s; tile[k * 65 + nc + 1] = v[1] * s; tile[k * 65 + nc + 2] = v[2] * s; tile[k * 65 + nc + 3] = v[3] * s;
        }
    }
    __syncthreads();
    {
        const int n = tid >> 3, kc = (tid & 7) * 8, gn = n0 + n;
        if (gn < N) {
            h16x8 o;
#pragma unroll
            for (int j = 0; j < 8; ++j) o[j] = (h16)tile[(kc + j) * 65 + n];
            h16* d;
            if (mode == 0) d = dst + (size_t)gn * K;
            else d = (gn < 2048) ? dst + (size_t)gn * K : (gn < 2064 ? dstG + (size_t)(gn - 2048) * K : dst + (size_t)(gn - 16) * K);
            *(h16x8*)(d + k0 + kc) = o;
        }
    }
    __syncthreads();
}

__device__ __forceinline__ void p0_prep(const Params& p, LAS unsigned char* lds) {
    unsigned char* ws = p.ws;
    LAS float* tile = (LAS float*)lds;
    for (int i = blockIdx.x * 512 + threadIdx.x; i < (MPAD - MALL) * D / 8; i += gridDim.x * 512) ((u32x4*)(ws + OFF_XN16 + (size_t)MALL * D * 2))[i] = (u32x4){0u, 0u, 0u, 0u};
    for (int i = blockIdx.x * 512 + threadIdx.x; i < 2 * MPAD; i += gridDim.x * 512) ((float*)(ws + OFF_SS1))[i] = 0.f;
    if (blockIdx.x == 0 && threadIdx.x < 64) ((unsigned*)(ws + OFF_CNT))[threadIdx.x] = 0u;
    constexpr int I_IN = 16 * 61, I_LW = 8, I_LA = 8, I_LG = 16;
    constexpr int NIT = I_IN + I_LW + I_LA + I_LG;
    for (int it = blockIdx.x; it < NIT; it += gridDim.x) {
        int r = it;
        if (r < I_IN) { tr_tile(p.in[9], 1024, 3856, r / 61, r % 61, tile, nullptr, (h16*)(ws + OFF_WT_IN), 1, (h16*)(ws + OFF_WT_G)); continue; } r -= I_IN;
        if (r < I_LW) { tr_tile(p.in[17], 64, 512, 0, r, tile, nullptr, (h16*)(ws + OFF_LW), 0, nullptr); continue; } r -= I_LW;
        if (r < I_LA) { tr_tile(p.in[19], 64, 512, 0, r, tile, nullptr, (h16*)(ws + OFF_LA), 0, nullptr); continue; } r -= I_LA;
        tr_tile(p.in[20], 128, 512, r / 8, r % 8, tile, nullptr, (h16*)(ws + OFF_LG), 0, nullptr);
    }
    const int lane = threadIdx.x & 63, wave = threadIdx.x >> 6;
    const float* nw = p.in[8];
    {
        f32x4 w4[4];
#pragma unroll
        for (int j = 0; j < 4; ++j) w4[j] = *(const f32x4*)(nw + lane * 4 + 256 * j);
        const int stride = gridDim.x * 8;
        for (int row = blockIdx.x * 8 + wave; row < MALL; row += 4 * stride) {
            f32x4 v[4][4]; float sq[4];
#pragma unroll
            for (int u = 0; u < 4; ++u) {
                const int r = row + u * stride, rc = r < MALL ? r : row;
                const float* xr = (rc < MP) ? p.in[0] + (size_t)rc * D : p.in[1] + (size_t)(rc - MP) * D;
                sq[u] = 0.f;
#pragma unroll
                for (int j = 0; j < 4; ++j) v[u][j] = *(const f32x4*)(xr + lane * 4 + 256 * j);
            }
#pragma unroll
            for (int u = 0; u < 4; ++u) {
#pragma unroll
                for (int j = 0; j < 4; ++j) sq[u] += v[u][j][0] * v[u][j][0] + v[u][j][1] * v[u][j][1] + v[u][j][2] * v[u][j][2] + v[u][j][3] * v[u][j][3];
                const float rstd = rsqrtf(wave_sum(sq[u]) * (1.f / D) + EPS);
                const int r = row + u * stride;
                if (r < MALL) {
                    h16* o = (h16*)(ws + OFF_XN16) + (size_t)r * D;
#pragma unroll
                    for (int j = 0; j < 4; ++j) *(h16x4*)(o + lane * 4 + 256 * j) = pack4(v[u][j] * rstd * w4[j]);
                }
            }
        }
    }
}

__device__ __forceinline__ float softplusf_(float z) { return fmaxf(z, 0.f) + __logf(1.f + __expf(-fabsf(z))); }
__device__ __forceinline__ void rwkv_prep_tile(const Params& p, LAS unsigned char* lds, int tile) {
    unsigned char* ws = p.ws;
    LAS h16* RS = (LAS h16*)lds;
    const int tid = threadIdx.x, lane = tid & 63, wave = tid >> 6, fr = lane & 15, fq = lane >> 4;
    const h16* PROJ = (const h16*)(ws + OFF_PROJ16);
    const float* mu = p.in[15];
    const int row0 = tile * 32;
    const int h = wave;
    const h16* LW = (const h16*)(ws + OFF_LW); const h16* LA = (const h16*)(ws + OFF_LA); const h16* LG = (const h16*)(ws + OFF_LG);
    auto finish_item = [&](const h16x8 cur, const float (&prev)[8], const f32x4 m0, const f32x4 m1, int i, int row, int c) {
        h16x8 o;
        const bool is_tanh = (c >= 1536 && c < 1600), is_sig = (c >= 1664);
        const float act_scale = is_tanh ? 2.f : 1.f;
#pragma unroll
        for (int j = 0; j < 8; ++j) {
            const float pj = (float)cur[j], mj = j < 4 ? m0[j] : m1[j - 4];
            float rs = pj + mj * (prev[j] - pj);
            const float sg = sigm(act_scale * rs);
            rs = is_tanh ? 2.f * sg - 1.f : (is_sig ? sg : rs);
            o[j] = (h16)rs;
        }
        *(LAS h16x8*)(RS + i * 1800 + c) = o;
        float* so = nullptr;
        if (row < MP) { if ((row & (SEQ - 1)) == SEQ - 1) so = p.out + O_PSH + (size_t)(row >> 11) * RWW + c; }
        else so = p.out + O_SSH + (size_t)(row - MP) * RWW + c;
        if (so) {
            f32x4 a, b;
#pragma unroll
            for (int j = 0; j < 4; ++j) { a[j] = (float)cur[j]; b[j] = (float)cur[4 + j]; }
            *(f32x4*)so = a; *(f32x4*)(so + 4) = b;
        }
    };
    if (row0 < MP) {
#pragma unroll 1
        for (int half = 0; half < 4; ++half) {
            h16x8 cur[4], pv[4];
#pragma unroll
            for (int k = 0; k < 4; ++k) {
                const int kk = (half * 4 + k) < 14 ? (half * 4 + k) : 13;
                const int it = tid + 512 * kk, i = it / 224, g = it - i * 224, row = row0 + i, c = g * 8;
                const int prow = (row & (SEQ - 1)) ? row - 1 : row;
                cur[k] = *(const h16x8*)(PROJ + (size_t)row * NPROJ + 2048 + c);
                pv[k] = *(const h16x8*)(PROJ + (size_t)prow * NPROJ + 2048 + c);
            }
#pragma unroll
            for (int k = 0; k < 4; ++k) {
                if (half * 4 + k >= 14) break;
                const int it = tid + 512 * (half * 4 + k), i = it / 224, g = it - i * 224, row = row0 + i, c = g * 8;
                const bool first = (row & (SEQ - 1)) == 0;
                float prev[8];
#pragma unroll
                for (int j = 0; j < 8; ++j) prev[j] = first ? 0.f : (float)pv[k][j];
                finish_item(cur[k], prev, *(const f32x4*)(mu + c), *(const f32x4*)(mu + c + 4), i, row, c);
            }
        }
    } else {
        for (int it = tid; it < 32 * 224; it += 512) {
            const int i = it / 224, g = it % 224, row = row0 + i, c = g * 8;
            const h16x8 cur = *(const h16x8*)(PROJ + (size_t)row * NPROJ + 2048 + c);
            float prev[8];
            const float* sh = p.in[7] + (size_t)(row - MP) * RWW + c;
            const f32x4 a = *(const f32x4*)sh, b = *(const f32x4*)(sh + 4);
#pragma unroll
            for (int j = 0; j < 4; ++j) { prev[j] = a[j]; prev[4 + j] = b[j]; }
            finish_item(cur, prev, *(const f32x4*)(mu + c), *(const f32x4*)(mu + c + 4), i, row, c);
        }
    }
    __syncthreads();
    f32x4 accW[2][4], accA[2][4], accG[2][4];
#pragma unroll
    for (int rt = 0; rt < 2; ++rt)
#pragma unroll
        for (int ct = 0; ct < 4; ++ct) { accW[rt][ct] = (f32x4){0.f, 0.f, 0.f, 0.f}; accA[rt][ct] = accW[rt][ct]; accG[rt][ct] = accW[rt][ct]; }
#pragma unroll
    for (int ks = 0; ks < 2; ++ks) {
        h16x8 aw[2], aa[2];
#pragma unroll
        for (int rt = 0; rt < 2; ++rt) { aw[rt] = *(const LAS h16x8*)(RS + (rt * 16 + fr) * 1800 + 1536 + ks * 32 + fq * 8); aa[rt] = *(const LAS h16x8*)(RS + (rt * 16 + fr) * 1800 + 1600 + ks * 32 + fq * 8); }
        h16x8 bw[4], ba[4];
#pragma unroll
        for (int ct = 0; ct < 4; ++ct) {
            bw[ct] = *(const h16x8*)(LW + (size_t)(h * 64 + ct * 16 + fr) * 64 + ks * 32 + fq * 8);
            ba[ct] = *(const h16x8*)(LA + (size_t)(h * 64 + ct * 16 + fr) * 64 + ks * 32 + fq * 8);
        }
#pragma unroll
        for (int ct = 0; ct < 4; ++ct)
#pragma unroll
            for (int rt = 0; rt < 2; ++rt) { accW[rt][ct] = mfma16(bw[ct], aw[rt], accW[rt][ct]); accA[rt][ct] = mfma16(ba[ct], aa[rt], accA[rt][ct]); }
    }
#pragma unroll
    for (int ks = 0; ks < 4; ++ks) {
        h16x8 ag[2];
#pragma unroll
        for (int rt = 0; rt < 2; ++rt) ag[rt] = *(const LAS h16x8*)(RS + (rt * 16 + fr) * 1800 + 1664 + ks * 32 + fq * 8);
        h16x8 bg[4];
#pragma unroll
        for (int ct = 0; ct < 4; ++ct) bg[ct] = *(const h16x8*)(LG + (size_t)(h * 64 + ct * 16 + fr) * 128 + ks * 32 + fq * 8);
#pragma unroll
        for (int ct = 0; ct < 4; ++ct)
#pragma unroll
            for (int rt = 0; rt < 2; ++rt) accG[rt][ct] = mfma16(bg[ct], ag[rt], accG[rt][ct]);
    }
    h16* OPS = (h16*)(ws + OFF_OPS16);
    h16* G16 = (h16*)((unsigned char*)p.out + OUTB_G16);
    float* RKS = (float*)(ws + OFF_RKS);
    float ss[2] = {0.f, 0.f}, rks[2] = {0.f, 0.f}, inv[2];
#pragma unroll
    for (int ct = 0; ct < 4; ++ct) {
        const int col = h * 64 + ct * 16 + fq * 4;
        const f32x4 kkw = *(const f32x4*)(p.in[21] + col);
#pragma unroll
        for (int rt = 0; rt < 2; ++rt) {
            const h16x4 k4 = *(const LAS h16x4*)(RS + (rt * 16 + fr) * 1800 + 512 + col);
#pragma unroll
            for (int r = 0; r < 4; ++r) { const float kk = (float)k4[r] * kkw[r]; ss[rt] += kk * kk; }
        }
    }
#pragma unroll
    for (int rt = 0; rt < 2; ++rt) {
        float s1 = ss[rt];
        s1 += __shfl_xor(s1, 16); s1 += __shfl_xor(s1, 32);
        inv[rt] = 1.f / fmaxf(sqrtf(s1), 1e-12f);
    }
#pragma unroll
    for (int ct = 0; ct < 4; ++ct) {
        const int c64 = ct * 16 + fq * 4, col = h * 64 + c64;
        const f32x4 w0 = *(const f32x4*)(p.in[16] + col), a0 = *(const f32x4*)(p.in[18] + col), kkw = *(const f32x4*)(p.in[21] + col),
                    kaw = *(const f32x4*)(p.in[22] + col), rkw = *(const f32x4*)(p.in[23] + col);
#pragma unroll
        for (int rt = 0; rt < 2; ++rt) {
            const int i = rt * 16 + fr, row = row0 + i;
            h16* ob = OPS + ((size_t)row * 8 + h) * 6 * 64;
            const h16x4 r4 = *(const LAS h16x4*)(RS + i * 1800 + col);
            const h16x4 k4 = *(const LAS h16x4*)(RS + i * 1800 + 512 + col);
            const h16x4 v4 = *(const LAS h16x4*)(RS + i * 1800 + 1024 + col);
            f32x4 wl, ke, na, nb;
#pragma unroll
            for (int r = 0; r < 4; ++r) {
                const float wraw = w0[r] + accW[rt][ct][r];
                wl[r] = -__expf(-softplusf_(-wraw) - 0.5f);
                const float a = sigm(a0[r] + accA[rt][ct][r]);
                const float kf = (float)k4[r], kn = kf * kkw[r] * inv[rt];
                na[r] = -kn; nb[r] = kn * a;
                ke[r] = kf * (1.f + (a - 1.f) * kaw[r]);
                rks[rt] += (float)r4[r] * ke[r] * rkw[r];
            }
            *(h16x4*)(ob + 0 * 64 + c64) = r4;
            *(h16x4*)(ob + 1 * 64 + c64) = pack4(wl);
            *(h16x4*)(ob + 2 * 64 + c64) = pack4(ke);
            *(h16x4*)(ob + 3 * 64 + c64) = v4;
            *(h16x4*)(ob + 4 * 64 + c64) = pack4(na);
            *(h16x4*)(ob + 5 * 64 + c64) = pack4(nb);
            *(h16x4*)(G16 + (size_t)row * 512 + col) = pack4(accG[rt][ct]);
        }
        __builtin_amdgcn_sched_barrier(0);
    }
#pragma unroll
    for (int rt = 0; rt < 2; ++rt) {
        const int row = row0 + rt * 16 + fr;
        float s2 = rks[rt];
        s2 += __shfl_xor(s2, 16); s2 += __shfl_xor(s2, 32);
        if (fq == 0) RKS[(size_t)row * 8 + h] = s2;
    }
    __syncthreads();
}

struct MlChain { int rowbase, T, h; const float* C0; const float* n0; const float* m0; const float* conv0; float* Cout; float* nout; float* mout; float* convout; };
typedef _Float16 h16x2 __attribute__((ext_vector_type(2)));
__device__ __forceinline__ void mlstm_chain(const Params& p, LAS unsigned char* lds, const MlChain ch) {
    unsigned char* ws = p.ws;
    LAS h16* XQ = (LAS h16*)lds;
    LAS h16* QS = (LAS h16*)(lds + 18432);
    LAS h16* KS = QS + 64 * 72; LAS h16* VT = KS + 64 * 72; LAS h16* KW = VT + 64 * 72; LAS h16* PP = KW + 64 * 72; LAS h16* CT = PP + 64 * 72;
    LAS float* SCL = (LAS float*)(lds + 73728);
    LAS float* DEN = SCL; LAS float* SSQ = SCL + 128; LAS float* NL = SCL + 256; LAS float* DQN = SCL + 320;
    LAS float* CBC = (LAS float*)(lds + 75264); LAS float* CUU = CBC + 2048; LAS float* CCM = CUU + 2048; LAS float* CBE = CCM + 2048; LAS float* CGM = CBE + 32;
    const int tid = threadIdx.x, lane = tid & 63, wave = tid >> 6, fr = lane & 15, fq = lane >> 4;
    const int h = ch.h, T = ch.T, rowbase = ch.rowbase;
    const h16* PROJ = (const h16*)(ws + OFF_PROJ16);
    const float* GATES = (const float*)(ws + OFF_GATES);
    h16* MIX = (h16*)((unsigned char*)p.out + OUTB_MIX16);
    const int kt = wave & 3;
    f32x4 Cacc[2];
#pragma unroll
    for (int j = 0; j < 2; ++j) {
        const int vt = (wave >> 2) * 2 + j;
#pragma unroll
        for (int r = 0; r < 4; ++r) Cacc[j][r] = ch.C0 ? ch.C0[(size_t)(kt * 16 + fq * 4 + r) * 64 + vt * 16 + fr] : 0.f;
    }
    const float n0v = (tid < 64 && ch.n0) ? ch.n0[tid] : 0.f;
    float mcur = ch.m0 ? ch.m0[0] : 0.f;
    const int cg8 = tid & 15, gcol0 = (cg8 < 8) ? h * 64 + cg8 * 8 : 512 + h * 64 + (cg8 - 8) * 8;
    float cw[4][8], cbv[8];
#pragma unroll
    for (int j = 0; j < 4; ++j) {
        const f32x4 w0 = *(const f32x4*)(p.in[10] + j * 1024 + gcol0), w1 = *(const f32x4*)(p.in[10] + j * 1024 + gcol0 + 4);
#pragma unroll
        for (int e = 0; e < 4; ++e) { cw[j][e] = w0[e]; cw[j][4 + e] = w1[e]; }
    }
    {
        const f32x4 b0 = *(const f32x4*)(p.in[11] + gcol0), b1 = *(const f32x4*)(p.in[11] + gcol0 + 4);
#pragma unroll
        for (int e = 0; e < 4; ++e) { cbv[e] = b0[e]; cbv[4 + e] = b1[e]; }
    }
    f32x4 nwv[2];
#pragma unroll
    for (int j = 0; j < 2; ++j) nwv[j] = *(const f32x4*)(p.in[14] + h * 64 + ((wave >> 2) * 2 + j) * 16 + fq * 4);
    const int nchunks = (T + 63) >> 6;
    for (int cc = wave; cc < nchunks; cc += 8) {
        const int tok = cc * 64 + lane;
        float ig = -INFINITY, lf = 0.f;
        if (tok < T) { const float* gp = GATES + (size_t)(rowbase + tok) * 16; ig = gp[h]; const float f = gp[8 + h]; lf = fminf(f, 0.f) - log1pf(__expf(-fabsf(f))); }
        float bc = lf;
#pragma unroll
        for (int o = 1; o < 64; o <<= 1) { const float t = __shfl_up(bc, o); if (lane >= o) bc += t; }
        const float u = ig - bc;
        float cm = u;
#pragma unroll
        for (int o = 1; o < 64; o <<= 1) { const float t = __shfl_up(cm, o); if (lane >= o) cm = fmaxf(cm, t); }
        const float bend = __shfl(bc, 63);
        const float gmax = wave_max(bend + u);
        CBC[cc * 64 + lane] = bc; CUU[cc * 64 + lane] = u; CCM[cc * 64 + lane] = cm;
        if (lane == 0) { CBE[cc] = bend; CGM[cc] = gmax; }
    }
    h16x8 pxq[3], pvv; h16x4 po[2];
    auto issue_loads = [&](int c) {
        const int t0 = c * 64, nv = (T - t0) < 64 ? (T - t0) : 64;
#pragma unroll
        for (int k = 0; k < 3; ++k) {
            const int it = tid + 512 * k;
            h16x8 v;
#pragma unroll
            for (int j = 0; j < 8; ++j) v[j] = (h16)0.f;
            if (it < 67 * 16) {
                const int i = it >> 4, g = it & 15, tok = t0 - 3 + i, c8 = g * 8;
                const int srccol = (g < 8) ? h * 64 + c8 : 512 + h * 64 + (c8 - 64);
                if (tok >= 0 && tok < T) v = *(const h16x8*)(PROJ + (size_t)(rowbase + tok) * NPROJ + srccol);
                else if (tok < 0 && ch.conv0) {
                    const float* cp = ch.conv0 + (size_t)(3 + tok) * 1024 + srccol;
#pragma unroll
                    for (int j = 0; j < 8; ++j) v[j] = (h16)cp[j];
                }
            }
            pxq[k] = v;
        }
        {
            const int s = tid & 63, g = tid >> 6;
            h16x8 v;
#pragma unroll
            for (int j = 0; j < 8; ++j) v[j] = (h16)0.f;
            if (s < nv) v = *(const h16x8*)(PROJ + (size_t)(rowbase + t0 + s) * NPROJ + 1024 + h * 64 + g * 8);
            pvv = v;
        }
        {
            const int t = (wave & 3) * 16 + fr;
#pragma unroll
            for (int j = 0; j < 2; ++j) {
                h16x4 o4;
#pragma unroll
                for (int r = 0; r < 4; ++r) o4[r] = (h16)0.f;
                if (t < nv) o4 = *(const h16x4*)(PROJ + (size_t)(rowbase + t0 + t) * NPROJ + 1536 + h * 64 + ((wave >> 2) * 2 + j) * 16 + fq * 4);
                po[j] = o4;
            }
        }
    };
    issue_loads(0);
#pragma unroll
    for (int j = 0; j < 2; ++j) *(LAS h16x4*)(CT + (((wave >> 2) * 2 + j) * 16 + fr) * 72 + kt * 16 + fq * 4) = pack4(Cacc[j]);
    if (tid < 64) NL[tid] = n0v;
    __syncthreads();
    for (int c = 0; c < nchunks; ++c) {
        const int t0 = c * 64, nv = (T - t0) < 64 ? (T - t0) : 64;
#pragma unroll
        for (int k = 0; k < 3; ++k) {
            const int it = tid + 512 * k;
            if (it < 67 * 16) *(LAS h16x8*)(XQ + (it >> 4) * 136 + (it & 15) * 8) = pxq[k];
        }
        {
            const int s = tid & 63, g = tid >> 6;
#pragma unroll
            for (int j = 0; j < 8; ++j) VT[(g * 8 + j) * 72 + s] = pvv[j];
        }
        const h16x4 oc0 = po[0], oc1 = po[1];
        const float bendc = CBE[c], mnew = fmaxf(bendc + mcur, CGM[c]), dec = __expf(bendc + mcur - mnew);
        lds_barrier();
        if (c + 1 < nchunks) issue_loads(c + 1);
        {
            const int s0 = (tid >> 4) * 2;
            h16x8 x[5];
#pragma unroll
            for (int j = 0; j < 5; ++j) x[j] = *(const LAS h16x8*)(XQ + (s0 + j) * 136 + cg8 * 8);
            float kw[2][8];
#pragma unroll
            for (int tk = 0; tk < 2; ++tk) {
                const int s = s0 + tk;
                h16x8 yo;
                float wsv = 0.f;
                if (cg8 >= 8) wsv = 0.125f * __expf(bendc + CUU[c * 64 + s] - mnew);
#pragma unroll
                for (int e = 0; e < 8; ++e) {
                    const float a = cbv[e] + (float)x[tk][e] * cw[0][e] + (float)x[tk + 1][e] * cw[1][e] + (float)x[tk + 2][e] * cw[2][e] + (float)x[tk + 3][e] * cw[3][e];
                    const float y = a * __builtin_amdgcn_rcpf(1.f + __expf(-a));
                    yo[e] = (h16)(cg8 < 8 ? y : 0.125f * y);
                    kw[tk][e] = y * wsv;
                }
                if (cg8 < 8) *(LAS h16x8*)(QS + s * 72 + cg8 * 8) = yo;
                else *(LAS h16x8*)(KS + s * 72 + (cg8 - 8) * 8) = yo;
            }
            if (cg8 >= 8) {
#pragma unroll
                for (int e = 0; e < 8; ++e) { h16x2 w2; w2[0] = (h16)kw[0][e]; w2[1] = (h16)kw[1][e]; *(LAS h16x2*)(KW + ((cg8 - 8) * 8 + e) * 72 + s0) = w2; }
            }
        }
        lds_barrier();
        {
            const int tt = wave & 3, sp = wave >> 2;
            h16x8 qa[2];
#pragma unroll
            for (int ks = 0; ks < 2; ++ks) qa[ks] = *(const LAS h16x8*)(QS + (tt * 16 + fr) * 72 + ks * 32 + fq * 8);
            float mx[4];
#pragma unroll
            for (int r = 0; r < 4; ++r) mx[r] = fmaxf(mcur, CCM[c * 64 + tt * 16 + fq * 4 + r]);
            float dpart[4] = {0.f, 0.f, 0.f, 0.f};
#pragma unroll
            for (int j = 0; j < 2; ++j) {
                const int st = sp * 2 + j;
                f32x4 acc = {0.f, 0.f, 0.f, 0.f};
#pragma unroll
                for (int ks = 0; ks < 2; ++ks) { const h16x8 kb = *(const LAS h16x8*)(KS + (st * 16 + fr) * 72 + ks * 32 + fq * 8); acc = mfma16(qa[ks], kb, acc); }
                const int s = st * 16 + fr; const float us = CUU[c * 64 + s];
#pragma unroll
                for (int r = 0; r < 4; ++r) {
                    const int t = tt * 16 + fq * 4 + r;
                    const float wgt = (s <= t) ? __expf(us - mx[r]) : 0.f;
                    const float pv = acc[r] * wgt; dpart[r] += pv; PP[t * 72 + s] = (h16)pv;
                }
            }
#pragma unroll
            for (int r = 0; r < 4; ++r) {
                float d = dpart[r]; d = row_sum16(d);
                if (fr == 0) DEN[sp * 64 + tt * 16 + fq * 4 + r] = d;
            }
            const int t = tid >> 3, part = tid & 7;
            const h16x8 q8 = *(const LAS h16x8*)(QS + t * 72 + part * 8);
            const f32x4 n0 = *(const LAS f32x4*)(NL + part * 8), n1 = *(const LAS f32x4*)(NL + part * 8 + 4);
            float a = 0.f;
#pragma unroll
            for (int j = 0; j < 4; ++j) a += (float)q8[j] * n0[j] + (float)q8[4 + j] * n1[j];
            a = dpp_add<0xB1>(a); a = dpp_add<0x4E>(a); a += __shfl_xor(a, 4);
            if (part == 0) DQN[t] = a;
        }
        lds_barrier();
        {
            const int tt = wave & 3, vp = wave >> 2, t = tt * 16 + fr;
            h16x8 pa[2], qa[2];
#pragma unroll
            for (int ks = 0; ks < 2; ++ks) { pa[ks] = *(const LAS h16x8*)(PP + t * 72 + ks * 32 + fq * 8); qa[ks] = *(const LAS h16x8*)(QS + t * 72 + ks * 32 + fq * 8); }
            const float mxt = fmaxf(mcur, CCM[c * 64 + t]);
            const float sc = __expf(mcur - mxt);
            const float den = DEN[t] + DEN[64 + t] + sc * DQN[t];
            const float inv = 1.f / fmaxf(fabsf(den), __expf(-(CBC[c * 64 + t] + mxt)));
            float hv[2][4], ssq = 0.f;
#pragma unroll
            for (int j = 0; j < 2; ++j) {
                const int vt = vp * 2 + j;
                f32x4 a1 = {0.f, 0.f, 0.f, 0.f}, a2 = {0.f, 0.f, 0.f, 0.f};
#pragma unroll
                for (int ks = 0; ks < 2; ++ks) {
                    const h16x8 vb = *(const LAS h16x8*)(VT + (vt * 16 + fr) * 72 + ks * 32 + fq * 8);
                    const h16x8 cbf = *(const LAS h16x8*)(CT + (vt * 16 + fr) * 72 + ks * 32 + fq * 8);
                    a1 = mfma16(vb, pa[ks], a1); a2 = mfma16(cbf, qa[ks], a2);
                }
                const h16x4 o4 = j == 0 ? oc0 : oc1;
#pragma unroll
                for (int r = 0; r < 4; ++r) { const float hh = (a1[r] + sc * a2[r]) * inv * sigm((float)o4[r]); hv[j][r] = hh; ssq += hh * hh; }
            }
            ssq += __shfl_xor(ssq, 16); ssq += __shfl_xor(ssq, 32);
            if (fq == 0) SSQ[vp * 64 + t] = ssq;
            lds_barrier();
            const float rstd = rsqrtf((SSQ[t] + SSQ[64 + t]) * (1.f / 64.f) + EPS);
            if (t < nv) {
#pragma unroll
                for (int j = 0; j < 2; ++j) {
                    const int v0 = h * 64 + (vp * 2 + j) * 16 + fq * 4;
                    const f32x4 nw = nwv[j];
                    f32x4 o;
#pragma unroll
                    for (int r = 0; r < 4; ++r) o[r] = hv[j][r] * rstd * nw[r];
                    *(h16x4*)(MIX + (size_t)(rowbase + t0 + t) * D + v0) = pack4(o);
                }
            }
        }
        {
#pragma unroll
            for (int j = 0; j < 2; ++j) {
                const int vt = (wave >> 2) * 2 + j;
                Cacc[j] *= dec;
#pragma unroll
                for (int ks = 0; ks < 2; ++ks) {
                    const h16x8 kwf = *(const LAS h16x8*)(KW + (kt * 16 + fr) * 72 + ks * 32 + fq * 8);
                    const h16x8 vf = *(const LAS h16x8*)(VT + (vt * 16 + fr) * 72 + ks * 32 + fq * 8);
                    Cacc[j] = mfma16(kwf, vf, Cacc[j]);
                }
                *(LAS h16x4*)(CT + (vt * 16 + fr) * 72 + kt * 16 + fq * 4) = pack4(Cacc[j]);
            }
            {
                const int kch = tid >> 3, part = tid & 7;
                const h16x8 x = *(const LAS h16x8*)(KW + kch * 72 + part * 8);
                float a = 0.f;
#pragma unroll
                for (int j = 0; j < 8; ++j) a += (float)x[j];
                a = dpp_add<0xB1>(a); a = dpp_add<0x4E>(a); a += __shfl_xor(a, 4);
                if (part == 0) NL[kch] = dec * NL[kch] + a;
            }
            mcur = mnew;
        }
        lds_barrier();
    }
#pragma unroll
    for (int j = 0; j < 2; ++j) {
        const int vt = (wave >> 2) * 2 + j;
#pragma unroll
        for (int r = 0; r < 4; ++r) ch.Cout[(size_t)(kt * 16 + fq * 4 + r) * 64 + vt * 16 + fr] = Cacc[j][r];
    }
    if (tid < 64) ch.nout[tid] = NL[tid];
    if (tid == 0) ch.mout[0] = mcur;
    if (tid < 384) {
        const int j = tid >> 7, cc = tid & 127, gcol = (cc < 64) ? h * 64 + cc : 512 + h * 64 + (cc - 64), tk = T - 3 + j;
        float v = 0.f;
        if (tk >= 0) v = (float)PROJ[(size_t)(rowbase + tk) * NPROJ + gcol];
        else if (ch.conv0) v = ch.conv0[(size_t)(3 + tk) * 1024 + gcol];
        ch.convout[(size_t)j * 1024 + gcol] = v;
    }
    __syncthreads();
}

__device__ __forceinline__ void mlstm_sample_task(const Params& p, int s, int h) {
    unsigned char* ws = p.ws;
    const int lane = threadIdx.x & 63, row = MP + s, i = s * 8 + h;
    const h16* pr = (const h16*)(ws + OFF_PROJ16) + (size_t)row * NPROJ;
    const float* C0 = p.in[2] + (size_t)i * 4096;
    float c0[64];
#pragma unroll
    for (int k = 0; k < 64; ++k) c0[k] = C0[k * 64 + lane];
    const int gq = h * 64 + lane, gk = 512 + h * 64 + lane;
    const float* cv = p.in[5] + (size_t)s * 3072;
    const float q0 = cv[gq], q1 = cv[1024 + gq], q2 = cv[2048 + gq], q3 = (float)pr[gq];
    const float k0 = cv[gk], k1 = cv[1024 + gk], k2 = cv[2048 + gk], k3 = (float)pr[gk];
    const float vv = (float)pr[1024 + h * 64 + lane], op = (float)pr[1536 + h * 64 + lane];
    const float* cwp = p.in[10];
    const float qc = p.in[11][gq] + q0 * cwp[gq] + q1 * cwp[1024 + gq] + q2 * cwp[2048 + gq] + q3 * cwp[3072 + gq];
    const float kc = p.in[11][gk] + k0 * cwp[gk] + k1 * cwp[1024 + gk] + k2 * cwp[2048 + gk] + k3 * cwp[3072 + gk];
    const float q = qc * sigm(qc), kk = kc * sigm(kc) * 0.125f;
    float* co = p.out + O_SCONV + (size_t)s * 3072;
    co[gq] = q1; co[1024 + gq] = q2; co[2048 + gq] = q3;
    co[gk] = k1; co[1024 + gk] = k2; co[2048 + gk] = k3;
    const float* gp = (const float*)(ws + OFF_GATES) + (size_t)row * 16;
    const float ig = gp[h], fg = gp[8 + h];
    const float lf = fminf(fg, 0.f) - __logf(1.f + __expf(-fabsf(fg)));
    const float m0 = p.in[4][i], n0 = p.in[3][(size_t)i * 64 + lane];
    const float inter = lf + m0, mt = fmaxf(inter, ig), wts = __expf(ig - mt), sc = __expf(inter - mt);
    const float qk = wave_sum(q * kk) * wts, qn = wave_sum(q * n0);
    const float den = qk + sc * qn, inv = 1.f / fmaxf(fabsf(den), __expf(-mt));
    float qc_acc = 0.f;
    float* Co = p.out + O_SC + (size_t)i * 4096;
    const int qb = __builtin_bit_cast(int, q), kb = __builtin_bit_cast(int, kk);
#pragma unroll
    for (int k = 0; k < 64; ++k) {
        const float qk_ = __builtin_bit_cast(float, __builtin_amdgcn_readlane(qb, k)), kk_ = __builtin_bit_cast(float, __builtin_amdgcn_readlane(kb, k));
        qc_acc += qk_ * c0[k];
        Co[k * 64 + lane] = sc * c0[k] + (wts * kk_) * vv;
    }
    const float hh = (qk * vv + sc * qc_acc) * inv * sigm(op);
    const float rstd = rsqrtf(wave_sum(hh * hh) * (1.f / 64.f) + EPS);
    ((h16*)((unsigned char*)p.out + OUTB_MIX16))[(size_t)row * D + gq] = (h16)(hh * rstd * p.in[14][gq]);
    p.out[O_SN + (size_t)i * 64 + lane] = sc * n0 + wts * kk;
    if (lane == 0) p.out[O_SM + i] = mt;
}
__device__ __forceinline__ void late_transposes(const Params& p, LAS unsigned char* lds, int w, int nw) {
    unsigned char* ws = p.ws;
    LAS float* tile = (LAS float*)lds;
    constexpr int I_OUT = 16 * 16, I_UP = 16 * 64, I_DN = 64 * 16;
    for (int it = w; it < I_OUT + I_UP + I_DN; it += nw) {
        int r = it;
        if (r < I_OUT) { tr_tile(p.in[26], 1024, 1024, r / 16, r % 16, tile, nullptr, (h16*)(ws + OFF_WT_OUT), 0, nullptr); continue; } r -= I_OUT;
        if (r < I_UP) { tr_tile(p.in[28], 1024, 4096, r / 64, r % 64, tile, p.in[27], (h16*)(ws + OFF_WT_UP), 0, nullptr); continue; } r -= I_UP;
        tr_tile(p.in[29], 4096, 1024, r / 16, r % 16, tile, nullptr, (h16*)(ws + OFF_WT_DN), 0, nullptr);
    }
}
__device__ __forceinline__ void p2_mixprep(const Params& p, LAS unsigned char* lds) {
    const int nb = gridDim.x, bid = blockIdx.x;
    if (bid < 64) {
        const int b = bid >> 3, h = bid & 7;
        MlChain ch; ch.rowbase = b * SEQ; ch.T = SEQ; ch.h = h; ch.C0 = nullptr; ch.n0 = nullptr; ch.m0 = nullptr; ch.conv0 = nullptr;
        ch.Cout = p.out + O_PC + (size_t)bid * 4096; ch.nout = p.out + O_PN + (size_t)bid * 64; ch.mout = p.out + O_PM + bid; ch.convout = p.out + O_PCONV + (size_t)b * 3072;
        mlstm_chain(p, lds, ch);
        return;
    }
    const int w = bid - 64, nw = nb - 64;
    for (int tile = w; tile < MALL / 32; tile += nw) rwkv_prep_tile(p, lds, tile);
    for (int i = w * 8 + (int)(threadIdx.x >> 6); i < MS * 8; i += nw * 8) mlstm_sample_task(p, i >> 3, i & 7);
    __syncthreads();
    late_transposes(p, lds, w, nw);
}

__device__ __forceinline__ void rwkv_scan_prompt(const Params& p, LAS unsigned char* lds, int bh, int rq) {
    constexpr int TC = 32, NCH = SEQ / TC, NPIECE = TC * 48 / 256;
    unsigned char* ws = p.ws;
    LAS float* OPS = (LAS float*)lds;
    LAS float* RKB = (LAS float*)(lds + 2 * TC * 6 * 64 * 4);
    const int tid = threadIdx.x, lane = tid & 63, wave = tid >> 6;
    const int b = bh >> 3, h = bh & 7, rowbase = b * SEQ;
    const h16* OPSG = (const h16*)(ws + OFF_OPS16);
    const float* RKS = (const float*)(ws + OFF_RKS);
    float* YRAW = (float*)(ws + OFF_YRAW);
    const int rr = lane >> 4, cg_ = lane & 15, rloc = (wave & 3) * 4 + rr;
    const int ltid = tid - 256;
    f32x4 S = {0.f, 0.f, 0.f, 0.f};
    h16x8 pre[NPIECE]; float prk = 0.f;
    auto issue_chunk = [&](int c) {
#pragma unroll
        for (int i = 0; i < NPIECE; ++i) {
            const int piece = ltid + 256 * i, tk = piece / 48, q = piece % 48, vec = q >> 3, c8 = q & 7;
            pre[i] = *(const h16x8*)(OPSG + (((size_t)(rowbase + c * TC + tk) * 8 + h) * 6 + vec) * 64 + c8 * 8);
        }
        if (ltid < TC) prk = RKS[(size_t)(rowbase + c * TC + ltid) * 8 + h];
    };
    auto store_chunk = [&](int buf) {
#pragma unroll
        for (int i = 0; i < NPIECE; ++i) {
            const int piece = ltid + 256 * i, tk = piece / 48, q = piece % 48, vec = q >> 3, c8 = q & 7;
            const h16x8 v = pre[i];
            f32x4 a, bb;
#pragma unroll
            for (int j = 0; j < 4; ++j) { a[j] = (float)v[j]; bb[j] = (float)v[4 + j]; }
            if (vec == 1) {
#pragma unroll
                for (int j = 0; j < 4; ++j) { a[j] = __expf(a[j]); bb[j] = __expf(bb[j]); }
            }
            LAS float* d = OPS + ((buf * TC + tk) * 6 + vec) * 64 + c8 * 8;
            *(LAS f32x4*)d = a; *(LAS f32x4*)(d + 4) = bb;
        }
        if (ltid < TC) RKB[buf * TC + ltid] = prk;
    };
    if (wave >= 4) { issue_chunk(0); store_chunk(0); issue_chunk(1); }
    lds_barrier();
    for (int c = 0; c < NCH; ++c) {
        const int buf = c & 1;
        if (wave >= 4) {
            if (c + 1 < NCH) store_chunk(buf ^ 1);
            if (c + 2 < NCH) issue_chunk(c + 2);
        } else {
            float yk[TC / 16];
#pragma unroll
            for (int j = 0; j < TC / 16; ++j) yk[j] = 0.f;
            const LAS float* ob = OPS + buf * TC * 6 * 64;
            f32x4 r4 = *(const LAS f32x4*)(ob + cg_ * 4), d4 = *(const LAS f32x4*)(ob + 64 + cg_ * 4), k4 = *(const LAS f32x4*)(ob + 128 + cg_ * 4),
                  a4 = *(const LAS f32x4*)(ob + 256 + cg_ * 4), b4 = *(const LAS f32x4*)(ob + 320 + cg_ * 4);
            float vv = ob[192 + rq * 16 + rloc];
            f32x4 rp = r4;
#pragma unroll
            for (int tk = 0; tk < TC; ++tk) {
                f32x4 nr4 = r4, nd4 = d4, nk4 = k4, na4 = a4, nb4 = b4; float nvv = vv;
                if (tk < TC - 1) {
                    const LAS float* o = ob + (tk + 1) * 6 * 64;
                    nr4 = *(const LAS f32x4*)(o + cg_ * 4); nd4 = *(const LAS f32x4*)(o + 64 + cg_ * 4); nk4 = *(const LAS f32x4*)(o + 128 + cg_ * 4);
                    na4 = *(const LAS f32x4*)(o + 256 + cg_ * 4); nb4 = *(const LAS f32x4*)(o + 320 + cg_ * 4);
                    nvv = o[192 + rq * 16 + rloc];
                }
                __builtin_amdgcn_sched_barrier(0);
                typedef float f32x2_ __attribute__((ext_vector_type(2)));
                f32x2_ ta = (f32x2_){S[0], S[1]} * (f32x2_){a4[0], a4[1]}; ta = (f32x2_){S[2], S[3]} * (f32x2_){a4[2], a4[3]} + ta;
                f32x2_ ty = (f32x2_){S[0], S[1]} * (f32x2_){rp[0], rp[1]}; ty = (f32x2_){S[2], S[3]} * (f32x2_){rp[2], rp[3]} + ty;
                const f32x4 T = S * d4 + vv * k4;
                float sa = ta[0] + ta[1];
                float yp = ty[0] + ty[1];
                sa = dpp_add<0xB1>(sa); yp = dpp_add<0xB1>(yp);
                sa = dpp_add<0x4E>(sa); yp = dpp_add<0x4E>(yp);
                sa = dpp_add<0x124>(sa); yp = dpp_add<0x124>(yp);
                sa = dpp_add<0x128>(sa); yp = dpp_add<0x128>(yp);
                if (tk > 0) yk[(tk - 1) >> 4] = (cg_ == ((tk - 1) & 15)) ? yp : yk[(tk - 1) >> 4];
                S = sa * b4 + T;
                rp = r4;
                r4 = nr4; d4 = nd4; k4 = nk4; a4 = na4; b4 = nb4; vv = nvv;
            }
            {
                float yp = S[0] * rp[0] + S[1] * rp[1] + S[2] * rp[2] + S[3] * rp[3];
                yp = row_sum16(yp);
                yk[(TC - 1) >> 4] = (cg_ == ((TC - 1) & 15)) ? yp : yk[(TC - 1) >> 4];
            }
#pragma unroll
            for (int j = 0; j < TC / 16; ++j) yk[j] += RKB[buf * TC + j * 16 + cg_] * ob[(j * 16 + cg_) * 6 * 64 + 192 + rq * 16 + rloc];
#pragma unroll
            for (int j = 0; j < TC / 16; ++j) YRAW[(size_t)(rowbase + c * TC + j * 16 + cg_) * 512 + h * 64 + rq * 16 + rloc] = yk[j];
        }
        lds_barrier();
    }
    if (wave < 4) *(f32x4*)(p.out + O_PS + ((size_t)bh * 64 + rq * 16 + rloc) * 64 + cg_ * 4) = S;
    __syncthreads();
}

__device__ __forceinline__ void rwkv_sample_task(const Params& p, int s, int h) {
    unsigned char* ws = p.ws;
    const int lane = threadIdx.x & 63, rr = lane >> 4, cg_ = lane & 15;
    const int row = MP + s;
    const h16* ob = (const h16*)(ws + OFF_OPS16) + ((size_t)row * 8 + h) * 6 * 64;
    f32x4 r4, d4, k4, a4, b4;
    {
        const h16x4 hr = *(const h16x4*)(ob + cg_ * 4), hw = *(const h16x4*)(ob + 64 + cg_ * 4), hk = *(const h16x4*)(ob + 128 + cg_ * 4),
                    ha = *(const h16x4*)(ob + 256 + cg_ * 4), hb = *(const h16x4*)(ob + 320 + cg_ * 4);
#pragma unroll
        for (int j = 0; j < 4; ++j) { r4[j] = (float)hr[j]; d4[j] = __expf((float)hw[j]); k4[j] = (float)hk[j]; a4[j] = (float)ha[j]; b4[j] = (float)hb[j]; }
    }
    const float rk = ((const float*)(ws + OFF_RKS))[(size_t)row * 8 + h];
    const float* S0 = p.in[6] + ((size_t)s * 8 + h) * 4096;
    float* So = p.out + O_SS + ((size_t)s * 8 + h) * 4096;
    float ysel = 0.f;
#pragma unroll
    for (int g = 0; g < 16; ++g) {
        const int vrow = g * 4 + rr;
        const float vv = (float)ob[192 + vrow];
        f32x4 S = *(const f32x4*)(S0 + (size_t)vrow * 64 + cg_ * 4);
        float sa = S[0] * a4[0] + S[1] * a4[1] + S[2] * a4[2] + S[3] * a4[3];
        sa = row_sum16(sa);
        S = S * d4 + sa * b4 + vv * k4;
        float y = S[0] * r4[0] + S[1] * r4[1] + S[2] * r4[2] + S[3] * r4[3];
        y = row_sum16(y) + rk * vv;
        *(f32x4*)(So + (size_t)vrow * 64 + cg_ * 4) = S;
        ysel = (cg_ == g) ? y : ysel;
    }
    const int vr = cg_ * 4 + rr, col = h * 64 + vr;
    const float mu = wave_sum(ysel) * (1.f / 64.f);
    const float dlt = ysel - mu;
    const float rstd = rsqrtf(wave_sum(dlt * dlt) * (1.f / 64.f) + GN_EPS);
    const float gte = (float)((const h16*)((unsigned char*)p.out + OUTB_G16))[(size_t)row * 512 + col];
    ((h16*)((unsigned char*)p.out + OUTB_MIX16))[(size_t)row * D + 512 + col] = (h16)((dlt * rstd * p.in[24][col] + p.in[25][col]) * gte);
}

__device__ __forceinline__ void p3_scan(const Params& p, LAS unsigned char* lds) {
    for (int j = blockIdx.x; j < 256; j += gridDim.x) {
        const int xcd = j & 7, slot = j >> 3;
        rwkv_scan_prompt(p, lds, xcd * 8 + (slot >> 2), slot & 3);
    }
    const int wave = threadIdx.x >> 6;
    for (int i = blockIdx.x * 8 + wave; i < MS * 8; i += gridDim.x * 8) rwkv_sample_task(p, i >> 3, i & 7);
}

__device__ __forceinline__ void groupnorm_rows(const Params& p, int rbeg, int rend) {
    unsigned char* ws = p.ws;
    const int lane = threadIdx.x & 63, wave = threadIdx.x >> 6, c = lane * 8;
    const float* YRAW = (const float*)(ws + OFF_YRAW);
    const h16* G16 = (const h16*)((unsigned char*)p.out + OUTB_G16);
    h16* MIX = (h16*)((unsigned char*)p.out + OUTB_MIX16);
    const f32x4 w0 = *(const f32x4*)(p.in[24] + c), w1 = *(const f32x4*)(p.in[24] + c + 4), b0 = *(const f32x4*)(p.in[25] + c), b1 = *(const f32x4*)(p.in[25] + c + 4);
    const int stride = 8;
    for (int row0 = rbeg + wave; row0 < rend; row0 += 4 * stride) {
        f32x4 ya[4], yb[4]; h16x8 gg[4];
#pragma unroll
        for (int u = 0; u < 4; ++u) {
            const int r = row0 + u * stride, rc = r < rend ? r : row0;
            ya[u] = *(const f32x4*)(YRAW + (size_t)rc * 512 + c); yb[u] = *(const f32x4*)(YRAW + (size_t)rc * 512 + c + 4);
            gg[u] = *(const h16x8*)(G16 + (size_t)rc * 512 + c);
        }
#pragma unroll
        for (int u = 0; u < 4; ++u) {
            const int row = row0 + u * stride;
            f32x4 y0 = ya[u], y1 = yb[u];
            float s = y0[0] + y0[1] + y0[2] + y0[3] + y1[0] + y1[1] + y1[2] + y1[3];
            s = dpp_add<0xB1>(s); s = dpp_add<0x4E>(s); s += __shfl_xor(s, 4);
            const float mu = s * (1.f / 64.f);
            y0 -= mu; y1 -= mu;
            float q = y0[0] * y0[0] + y0[1] * y0[1] + y0[2] * y0[2] + y0[3] * y0[3] + y1[0] * y1[0] + y1[1] * y1[1] + y1[2] * y1[2] + y1[3] * y1[3];
            q = dpp_add<0xB1>(q); q = dpp_add<0x4E>(q); q += __shfl_xor(q, 4);
            const float rstd = rsqrtf(q * (1.f / 64.f) + GN_EPS);
            f32x4 o0, o1;
#pragma unroll
            for (int j = 0; j < 4; ++j) { o0[j] = (y0[j] * rstd * w0[j] + b0[j]) * (float)gg[u][j]; o1[j] = (y1[j] * rstd * w1[j] + b1[j]) * (float)gg[u][4 + j]; }
            if (row < rend) *(h16x8*)(MIX + (size_t)row * D + 512 + c) = pack8(o0, o1);
        }
    }
}

__device__ __forceinline__ void p7_final(const Params& p, bool prompt_done) {
    unsigned char* ws = p.ws;
    const int lane = threadIdx.x & 63, wave = threadIdx.x >> 6;
    const float* nw = p.in[30];
    const float* SS2 = (const float*)(ws + OFF_SS2);
    const h16* X2 = (const h16*)(ws + OFF_X1);
    f32x4 w[4];
#pragma unroll
    for (int j = 0; j < 4; ++j) w[j] = *(const f32x4*)(nw + lane * 4 + 256 * j);
    const int stride = gridDim.x * 8;
    if (!prompt_done)
    for (int row = blockIdx.x * 8 + wave; row < MP; row += 4 * stride) {
        h16x4 v[4][4]; float rstd[4];
#pragma unroll
        for (int u = 0; u < 4; ++u) {
            const int r = row + u * stride, rc = r < MP ? r : row;
            rstd[u] = rsqrtf(SS2[rc] * (1.f / D) + EPS);
#pragma unroll
            for (int j = 0; j < 4; ++j) v[u][j] = *(const h16x4*)(X2 + (size_t)rc * D + lane * 4 + 256 * j);
        }
#pragma unroll
        for (int u = 0; u < 4; ++u) {
            const int r = row + u * stride;
            if (r < MP) {
#pragma unroll
                for (int j = 0; j < 4; ++j) {
                    f32x4 o;
#pragma unroll
                    for (int e = 0; e < 4; ++e) o[e] = (float)v[u][j][e] * rstd[u] * w[j][e];
                    *(f32x4*)(p.out + O_YP + (size_t)r * D + lane * 4 + 256 * j) = o;
                }
            }
        }
    }
    for (int s = blockIdx.x * 8 + wave; s < MS; s += stride) {
        float* xr = p.out + O_YS + (size_t)s * D;
        const float rstd = rsqrtf(SS2[MP + s] * (1.f / D) + EPS);
#pragma unroll
        for (int j = 0; j < 4; ++j) { const f32x4 v = *(const f32x4*)(xr + lane * 4 + 256 * j); *(f32x4*)(xr + lane * 4 + 256 * j) = v * rstd * w[j]; }
    }
}

__global__ void __launch_bounds__(512, 2) hymba_fwd(Params p) {
    extern __shared__ __attribute__((aligned(16))) unsigned char shm[];
    LAS unsigned char* lds = (LAS unsigned char*)shm;
    cg::grid_group grid = cg::this_grid();
    unsigned char* ws = p.ws;
    const int G = gridDim.x, c = blockIdx.x;

    XB xb; xb.bar = (unsigned*)(ws + OFF_BAR); xb.x = xb_xcc_id();
    if (c == 0) for (int i = threadIdx.x; i < 2176; i += 512) xb.bar[1024 + i] = 0u;
    if (threadIdx.x == 0) xb.bar[3200 + c] = xb.x;
    p0_prep(p, lds);
    grid.sync();
    {
        LAS unsigned* hist = (LAS unsigned*)lds;
        if (threadIdx.x < 16) hist[threadIdx.x] = 0u;
        __syncthreads();
        for (int i = threadIdx.x; i < G; i += 512) atomicAdd((unsigned*)(hist + (xb_ld(&xb.bar[3200 + i]) & 15u)), 1u);
        __syncthreads();
        unsigned cnt = 0u;
#pragma unroll
        for (unsigned j = 0; j < 16; ++j) cnt += (hist[j] > 0u) ? 1u : 0u;
        const unsigned mine = hist[xb.x];
        xb.nloc = mine > 0u ? mine : 1u; xb.nx = cnt > 0u ? cnt : 1u;
        __syncthreads();
    }
    {
        pg8::Gemm g{(const h16*)(ws + OFF_XN16), (const h16*)(ws + OFF_WT_IN), MPAD, NPROJ, D};
        pg8::StaticOrder S; S.init(MPAD, NPROJ, G, c);
        Epi<0> E{(h16*)(ws + OFF_PROJ16), NPROJ, nullptr, 0, nullptr, 0, nullptr, nullptr};
        pg8::gemm_phase(lds, g, S, E);
        skinny<SK_GATES>(p, (const h16*)(ws + OFF_XN16), D, 0, MALL / 16, (const h16*)(ws + OFF_WT_G), D, 1);
    }
    xcd_barrier(xb);
    p2_mixprep(p, lds);
    xcd_barrier(xb);
    p3_scan(p, lds);
    xcd_barrier(xb);
    {
        const h16* MIX = (const h16*)((unsigned char*)p.out + OUTB_MIX16);
        pg8::Gemm g{MIX, (const h16*)(ws + OFF_WT_OUT), MP, D, D};
        pg8::StaticOrder S; S.init(MP, D, G, c);
        { pg8::Unit u0; for (int i = 0; S.next(i, u0); ++i) groupnorm_rows(p, u0.pm * 256, u0.pm * 256 + 256); }
        asm volatile("s_waitcnt vmcnt(0)" ::: "memory");
        __syncthreads();
        Epi<1> E{(h16*)(ws + OFF_X116), D, nullptr, 0, p.in[0], D, (float*)(ws + OFF_SS1), nullptr};
        pg8::gemm_phase(lds, g, S, E);
        skinny<SK_OUT>(p, MIX, D, MP, MS / 16, (const h16*)(ws + OFF_WT_OUT), D, D / 16);
    }
    xcd_barrier(xb);
    {
        pg8::Gemm g{(const h16*)(ws + OFF_X116), (const h16*)(ws + OFF_WT_UP), MP, DFF, D};
        pg8::StaticOrder S; S.init(MP, DFF, G, c);
        Epi<2> E{(h16*)(ws + OFF_HID16), DFF, nullptr, 0, nullptr, 0, (float*)(ws + OFF_SS1), nullptr};
        pg8::gemm_phase(lds, g, S, E);
        skinny<SK_UP>(p, (const h16*)(ws + OFF_X116), D, MP, MS / 16, (const h16*)(ws + OFF_WT_UP), D, DFF / 16);
    }
    xcd_barrier(xb);
    {
        pg8::Gemm g{(const h16*)(ws + OFF_HID16), (const h16*)(ws + OFF_WT_DN), MP, D, DFF};
        pg8::StaticOrder S; S.init(MP, D, G, c);
        if (G == 256) {
            EpiFinal E{p.out + O_YP, (const h16*)(ws + OFF_X116), (float*)(ws + OFF_SS2), (unsigned*)(ws + OFF_CNT), p.in[30]};
            pg8::gemm_phase(lds, g, S, E);
        } else {
            Epi<3> E{(h16*)(ws + OFF_X1), D, nullptr, 0, nullptr, D, (float*)(ws + OFF_SS2), (const h16*)(ws + OFF_X116)};
            pg8::gemm_phase(lds, g, S, E);
        }
        skinny_down_splitk(p, lds);
    }
    xcd_barrier(xb);
    p7_final(p, G == 256);
}

extern "C" void kernel_launch(void* const* d_in, const int* in_sizes, int n_in, void* d_out, int out_size, void* d_ws, size_t ws_size, hipStream_t stream) {
    static int grid_blocks = 0;
    if (grid_blocks == 0) {
        int dev = 0, cus = 0, per_cu = 0;
        (void)hipGetDevice(&dev);
        (void)hipDeviceGetAttribute(&cus, hipDeviceAttributeMultiprocessorCount, dev);
        if (hipFuncSetAttribute((const void*)hymba_fwd, hipFuncAttributeMaxDynamicSharedMemorySize, LDS_BYTES) != hipSuccess) fprintf(stderr, "hipFuncSetAttribute failed\n");
        if (hipOccupancyMaxActiveBlocksPerMultiprocessor(&per_cu, (const void*)hymba_fwd, 512, LDS_BYTES) != hipSuccess || per_cu < 1) { fprintf(stderr, "occupancy query: %d\n", per_cu); per_cu = 1; }
        (void)hipGetLastError();
        grid_blocks = cus;
        if (ws_size < 268435456ull) fprintf(stderr, "workspace too small: %zu\n", ws_size);
    }
    Params p{};
    for (int i = 0; i < 31; ++i) p.in[i] = (const float*)d_in[i];
    p.out = (float*)d_out; p.ws = (unsigned char*)d_ws;
    void* args[] = {&p};
    hipError_t e = hipLaunchCooperativeKernel((const void*)hymba_fwd, dim3(grid_blocks), dim3(512), args, LDS_BYTES, stream);
    if (e != hipSuccess) fprintf(stderr, "cooperative launch failed: %s (grid %d)\n", hipGetErrorString(e), grid_blocks);
}
```
